# Optimizing an MI355X kernel written in HIP

```python
import math
import jax, jax.numpy as jnp
from jax import lax
import numpy as np

D_MODEL = 1024
BATCH = 8
SEQ = 4096
DEPTH = 4

GRID_W = 64
CTX_LEN = 256
EPS = 1e-6
ROPE_BASE = 10000.0
NEG = -1e30

MLA_HEADS = 8
MLA_NOPE = 64
MLA_ROPE = 32
MLA_V = 64
MLA_QK = MLA_NOPE + MLA_ROPE
MLA_Q_RANK = 384
MLA_KV_RANK = 256
MLA_WIDTH = MLA_HEADS * MLA_V
Q_BLOCK = 128

SWA_HEADS = 8
SWA_KV_HEADS = 2
SWA_DIM = 64
SWA_WINDOW = 128
SWA_BLOCK = 128
SWA_WIDTH = SWA_HEADS * SWA_DIM

S5_GROUP = 16
S5_GROUPS = 32
S5_STATE = 64
S5_WIDTH = S5_GROUP * S5_GROUPS

MIX_WIDTH = MLA_WIDTH + SWA_WIDTH + S5_WIDTH
IN_SPLITS = (MLA_Q_RANK, MLA_KV_RANK, MLA_ROPE, MLA_WIDTH,
             SWA_HEADS * SWA_DIM, SWA_KV_HEADS * SWA_DIM, SWA_KV_HEADS * SWA_DIM, SWA_WIDTH,
             S5_WIDTH, S5_WIDTH)
IN_WIDTH = 3488

kernel_name = "hybrid_parallel_mla_swa_s5_dit"


def rmsnorm(x, g):
    xf = x.astype(jnp.float32)
    y = xf * lax.rsqrt(jnp.mean(xf * xf, axis=-1, keepdims=True) + EPS)
    return (y * g.astype(jnp.float32)).astype(x.dtype)


def modulate(x, g, shift, scale):
    return rmsnorm(x, g) * (1.0 + scale) + shift


def split_cols(z):
    offs = [int(o) for o in np.cumsum(IN_SPLITS)[:-1]]
    return jnp.split(z, offs, axis=-1)


def axial_rope(row, col, rot_dim):
    n_freq = rot_dim // 4
    freqs = ROPE_BASE ** (-jnp.arange(n_freq, dtype=jnp.float32) / n_freq)
    ang = jnp.concatenate([row.astype(jnp.float32)[:, None] * freqs,
                           col.astype(jnp.float32)[:, None] * freqs], axis=-1)
    return jnp.cos(ang), jnp.sin(ang)


def rope_tail(x, start, rope):
    cos, sin = rope
    xr = x[..., start:].astype(jnp.float32)
    d2 = xr.shape[-1] // 2
    x1, x2 = xr[..., :d2], xr[..., d2:]
    cs, sn = cos[:, None, :], sin[:, None, :]
    rot = jnp.concatenate([x1 * cs - x2 * sn, x2 * cs + x1 * sn], axis=-1).astype(x.dtype)
    return jnp.concatenate([x[..., :start], rot], axis=-1)


def mla_q(cq, g_cq, w_uq, g_qn, rope):
    B, L, _ = cq.shape
    q = rmsnorm((rmsnorm(cq, g_cq) @ w_uq).reshape(B, L, MLA_HEADS, MLA_QK), g_qn)
    return q if rope is None else rope_tail(q, MLA_NOPE, rope)


def mla_kv(ckv, kr, g_ckv, w_ukv, g_kn, rope):
    B, L, _ = ckv.shape
    kv = (rmsnorm(ckv, g_ckv) @ w_ukv).reshape(B, L, MLA_HEADS, MLA_NOPE + MLA_V)
    k_rope = jnp.broadcast_to(kr[:, :, None, :], (B, L, MLA_HEADS, MLA_ROPE))
    k = rmsnorm(jnp.concatenate([kv[..., :MLA_NOPE], k_rope], axis=-1), g_kn)
    if rope is not None:
        k = rope_tail(k, MLA_NOPE, rope)
    return k, kv[..., MLA_NOPE:]


def dense_attention(q, k, v):
    B, Lq, H, d = q.shape
    s = jnp.einsum('bqhd,bkhd->bhqk', q, k, preferred_element_type=jnp.float32) * (d ** -0.5)
    p = jax.nn.softmax(s, axis=-1).astype(v.dtype)
    return jnp.einsum('bhqk,bkhd->bqhd', p, v).reshape(B, Lq, -1)


def mla_latent_attention(q, k, v, k_c, v_c):
    B, L, H, d = q.shape
    nb = L // Q_BLOCK
    C = k_c.shape[1]
    scale = d ** -0.5
    qb = q.reshape(B, nb, Q_BLOCK, H, d).transpose(1, 0, 2, 3, 4)

    def one_block(qi):
        s_c = jnp.einsum('bqhd,bkhd->bhqk', qi, k_c, preferred_element_type=jnp.float32) * scale
        s_l = jnp.einsum('bqhd,bkhd->bhqk', qi, k, preferred_element_type=jnp.float32) * scale
        p = jax.nn.softmax(jnp.concatenate([s_c, s_l], axis=-1), axis=-1).astype(v.dtype)
        return (jnp.einsum('bhqk,bkhd->bqhd', p[..., :C], v_c)
                + jnp.einsum('bhqk,bkhd->bqhd', p[..., C:], v))

    out = lax.map(one_block, qb)
    return out.transpose(1, 0, 2, 3, 4).reshape(B, L, H * v.shape[-1])


def swa_heads(z, n_heads, g, rope):
    B, L, _ = z.shape
    h = rmsnorm(z.reshape(B, L, n_heads, SWA_DIM), g)
    return h if rope is None else rope_tail(h, 0, rope)


def sink_logits(sink, lead_shape):
    s = sink.astype(jnp.float32).reshape(SWA_KV_HEADS, SWA_HEADS // SWA_KV_HEADS)
    return jnp.broadcast_to(s[:, :, None, None], lead_shape + (1,))


def swa_latent_attention(q, k, v, k_c, v_c, sink):
    B, L, H, d = q.shape
    KV, G, W = SWA_KV_HEADS, H // SWA_KV_HEADS, SWA_BLOCK
    nb = L // W
    C = k_c.shape[1]
    scale = d ** -0.5
    qb = q.reshape(B, nb, W, KV, G, d)
    pad = ((0, 0), (W, W), (0, 0), (0, 0))
    kp = jnp.pad(k, pad).reshape(B, nb + 2, W, KV, d)
    vp = jnp.pad(v, pad).reshape(B, nb + 2, W, KV, d)
    band = lambda t: jnp.concatenate([t[:, :-2], t[:, 1:-1], t[:, 2:]], axis=2)
    kw, vw = band(kp), band(vp)
    rel = jnp.arange(3 * W)[None, :] - W - jnp.arange(W)[:, None]
    key_pos = jnp.arange(nb)[:, None] * W - W + jnp.arange(3 * W)[None, :]
    valid = (jnp.abs(rel) <= SWA_WINDOW)[None] & ((key_pos >= 0) & (key_pos < L))[:, None, :]
    s_w = jnp.einsum('bnqhgd,bnkhd->bnhgqk', qb, kw, preferred_element_type=jnp.float32) * scale
    s_w = jnp.where(valid[None, :, None, None], s_w, NEG)
    s_c = jnp.einsum('bnqhgd,bchd->bnhgqc', qb, k_c, preferred_element_type=jnp.float32) * scale
    s_s = sink_logits(sink, (B, nb, KV, G, W))[..., None, :, :, :, :].reshape(B, nb, KV, G, W, 1) \
        if False else jnp.broadcast_to(
            sink.astype(jnp.float32).reshape(KV, G)[None, None, :, :, None, None], (B, nb, KV, G, W, 1))
    p = jax.nn.softmax(jnp.concatenate([s_s, s_c, s_w], axis=-1), axis=-1).astype(v.dtype)
    o = (jnp.einsum('bnhgqc,bchd->bnqhgd', p[..., 1:1 + C], v_c)
         + jnp.einsum('bnhgqk,bnkhd->bnqhgd', p[..., 1 + C:], vw))
    return o.reshape(B, L, H * d)


def swa_context_attention(q, k, v, sink):
    B, C, H, d = q.shape
    KV, G = SWA_KV_HEADS, H // SWA_KV_HEADS
    qg = q.reshape(B, C, KV, G, d)
    s = jnp.einsum('bqhgd,bchd->bhgqc', qg, k, preferred_element_type=jnp.float32) * (d ** -0.5)
    s_s = jnp.broadcast_to(sink.astype(jnp.float32).reshape(KV, G)[None, :, :, None, None], (B, KV, G, C, 1))
    p = jax.nn.softmax(jnp.concatenate([s_s, s], axis=-1), axis=-1)[..., 1:].astype(v.dtype)
    return jnp.einsum('bhgqc,bchd->bqhgd', p, v).reshape(B, C, H * d)


def _linrec(e1, e2):
    a1, b1 = e1
    a2, b2 = e2
    return a1 * a2, a2 * b1 + b2


def s5_scan(a_bar, bu, reverse):
    a = jnp.broadcast_to(a_bar[None, None], (bu.shape[0], 1) + a_bar.shape)
    _, h = lax.associative_scan(_linrec, (a, bu), reverse=reverse, axis=0)
    return h


def s5_direction(ug, ugc, a_re, a_im, log_dt, b_re, b_im, c_re, c_im, reverse, with_ctx):
    f32 = jnp.float32
    A = lax.complex(a_re.astype(f32), a_im.astype(f32))
    a_bar = jnp.exp(jnp.exp(log_dt.astype(f32))[:, None] * A)
    b_bar = ((a_bar - 1.0) / A)[..., None] * lax.complex(b_re.astype(f32), b_im.astype(f32))
    c_mat = lax.complex(c_re.astype(f32), c_im.astype(f32))
    drive = lambda u: jnp.einsum('blgp,gnp->lbgn', u.astype(jnp.complex64), b_bar)
    readout = lambda h: jnp.einsum('lbgn,gpn->blgp', h, c_mat).real
    h_c = s5_scan(a_bar, drive(ugc), reverse)
    h_init = h_c[0] if reverse else h_c[-1]
    bu = drive(ug)
    bu = bu.at[-1 if reverse else 0].add(a_bar[None] * h_init)
    h = s5_scan(a_bar, bu, reverse)
    y = readout(h)
    y_c = readout(h_c) if with_ctx else None
    return y, y_c


def s5_glu(y, w_glu):
    z = jax.nn.gelu(y) @ w_glu
    za, zb = jnp.split(z, 2, axis=-1)
    return za * jax.nn.sigmoid(zb)


def s5_branch(u, u_c, a_re, a_im, log_dt, b_re, b_im, c_re, c_im, d, w_glu, with_ctx):
    B, L, _ = u.shape
    C = u_c.shape[1]
    ug = u.reshape(B, L, S5_GROUPS, S5_GROUP)
    ugc = u_c.reshape(B, C, S5_GROUPS, S5_GROUP)
    y = (d * u).astype(jnp.float32)
    y_c = (d * u_c).astype(jnp.float32)
    for direc in range(2):
        yl, yc = s5_direction(ug, ugc, a_re[direc], a_im[direc], log_dt[direc], b_re[direc], b_im[direc],
                              c_re[direc], c_im[direc], direc == 1, with_ctx)
        y = y + yl.reshape(B, L, S5_WIDTH)
        if with_ctx:
            y_c = y_c + yc.reshape(B, C, S5_WIDTH)
    out = s5_glu(y.astype(u.dtype), w_glu)
    out_c = s5_glu(y_c.astype(u.dtype), w_glu) if with_ctx else None
    return out, out_c


def setup_inputs(seed: int = 0) -> dict:
    key = jax.random.key(seed)
    ks = jax.random.split(key, 28)
    f32 = jnp.float32
    D = D_MODEL

    def nrm(k, shape, s):
        return jax.random.normal(k, shape, f32) * s

    n_idx = jnp.arange(S5_STATE, dtype=f32)
    s5_shape = (DEPTH, 2, S5_GROUPS, S5_STATE)
    return {
        "x": nrm(ks[0], (BATCH, SEQ, D), 1.0),
        "c": nrm(ks[1], (BATCH, D), 1.0),
        "ctx": nrm(ks[2], (BATCH, CTX_LEN, D), 1.0),
        "c_ctx": nrm(ks[3], (D,), 1.0),
        "norm_g": 1.0 + nrm(ks[4], (DEPTH, D), 0.02),
        "w_ada": nrm(ks[5], (DEPTH, D, 3 * D), 0.5 * D ** -0.5),
        "b_ada": nrm(ks[6], (DEPTH, 3 * D), 0.02),
        "w_in": nrm(ks[7], (DEPTH, D, IN_WIDTH), D ** -0.5),
        "w_out": nrm(ks[8], (DEPTH, MIX_WIDTH, D), MIX_WIDTH ** -0.5),
        "mla_g_cq": 1.0 + nrm(ks[9], (DEPTH, MLA_Q_RANK), 0.02),
        "mla_g_ckv": 1.0 + nrm(ks[10], (DEPTH, MLA_KV_RANK), 0.02),
        "mla_w_uq": nrm(ks[11], (DEPTH, MLA_Q_RANK, MLA_HEADS * MLA_QK), MLA_Q_RANK ** -0.5),
        "mla_w_ukv": nrm(ks[12], (DEPTH, MLA_KV_RANK, MLA_HEADS * (MLA_NOPE + MLA_V)), MLA_KV_RANK ** -0.5),
        "mla_g_qn": 1.0 + nrm(ks[13], (DEPTH, MLA_QK), 0.02),
        "mla_g_kn": 1.0 + nrm(ks[14], (DEPTH, MLA_QK), 0.02),
        "swa_g_qn": 1.0 + nrm(ks[15], (DEPTH, SWA_DIM), 0.02),
        "swa_g_kn": 1.0 + nrm(ks[16], (DEPTH, SWA_DIM), 0.02),
        "swa_sink": nrm(ks[17], (DEPTH, SWA_HEADS), 0.5),
        "s5_a_re": -0.5 + nrm(ks[18], s5_shape, 0.01),
        "s5_a_im": math.pi * n_idx + nrm(ks[19], s5_shape, 0.01),
        "s5_log_dt": jax.random.uniform(ks[20], (DEPTH, 2, S5_GROUPS), f32, math.log(1e-3), math.log(1e-1)),
        "s5_b_re": nrm(ks[21], (DEPTH, 2, S5_GROUPS, S5_STATE, S5_GROUP), (2 * S5_GROUP) ** -0.5),
        "s5_b_im": nrm(ks[22], (DEPTH, 2, S5_GROUPS, S5_STATE, S5_GROUP), (2 * S5_GROUP) ** -0.5),
        "s5_c_re": nrm(ks[23], (DEPTH, 2, S5_GROUPS, S5_GROUP, S5_STATE), S5_STATE ** -0.5),
        "s5_c_im": nrm(ks[24], (DEPTH, 2, S5_GROUPS, S5_GROUP, S5_STATE), S5_STATE ** -0.5),
        "s5_d": nrm(ks[25], (DEPTH, S5_WIDTH), 0.5),
        "s5_w_glu": nrm(ks[26], (DEPTH, S5_WIDTH, 2 * S5_WIDTH), S5_WIDTH ** -0.5),
    }


def reference(x, c, ctx, c_ctx, norm_g, w_ada, b_ada, w_in, w_out,
              mla_g_cq, mla_g_ckv, mla_w_uq, mla_w_ukv, mla_g_qn, mla_g_kn,
              swa_g_qn, swa_g_kn, swa_sink,
              s5_a_re, s5_a_im, s5_log_dt, s5_b_re, s5_b_im, s5_c_re, s5_c_im, s5_d, s5_w_glu):
    n_lat = x.shape[1]
    rows = n_lat // GRID_W
    r_idx, c_idx = jnp.meshgrid(jnp.arange(rows), jnp.arange(GRID_W), indexing="ij")
    r_idx, c_idx = r_idx.reshape(-1), c_idx.reshape(-1)
    rope_mla = axial_rope(r_idx, c_idx, MLA_ROPE)
    rope_swa = axial_rope(r_idx, c_idx, SWA_DIM)
    silu_c = jax.nn.silu(c)
    silu_cc = jax.nn.silu(c_ctx)

    for l in range(DEPTH):
        upd_ctx = l < DEPTH - 1
        shift, scale, gate = jnp.split((silu_c @ w_ada[l] + b_ada[l])[:, None, :], 3, axis=-1)
        shift_c, scale_c, gate_c = jnp.split(silu_cc @ w_ada[l] + b_ada[l], 3, axis=-1)
        (cq, ckv, kr, g_mla, sq, sk, sv, g_swa, u, g_s5) = split_cols(
            modulate(x, norm_g[l], shift, scale) @ w_in[l])
        (cq_c, ckv_c, kr_c, g_mla_c, sq_c, sk_c, sv_c, g_swa_c, u_c, g_s5_c) = split_cols(
            modulate(ctx, norm_g[l], shift_c, scale_c) @ w_in[l])

        k_a, v_a = mla_kv(ckv, kr, mla_g_ckv[l], mla_w_ukv[l], mla_g_kn[l], rope_mla)
        k_ac, v_ac = mla_kv(ckv_c, kr_c, mla_g_ckv[l], mla_w_ukv[l], mla_g_kn[l], None)
        q_a = mla_q(cq, mla_g_cq[l], mla_w_uq[l], mla_g_qn[l], rope_mla)
        o_a = mla_latent_attention(q_a, k_a, v_a, k_ac, v_ac)

        q_b = swa_heads(sq, SWA_HEADS, swa_g_qn[l], rope_swa)
        k_b = swa_heads(sk, SWA_KV_HEADS, swa_g_kn[l], rope_swa)
        v_b = sv.reshape(sv.shape[0], n_lat, SWA_KV_HEADS, SWA_DIM)
        k_bc = swa_heads(sk_c, SWA_KV_HEADS, swa_g_kn[l], None)
        v_bc = sv_c.reshape(sv_c.shape[0], sv_c.shape[1], SWA_KV_HEADS, SWA_DIM)
        o_b = swa_latent_attention(q_b, k_b, v_b, k_bc, v_bc, swa_sink[l])

        o_c, o_cc = s5_branch(u, u_c, s5_a_re[l], s5_a_im[l], s5_log_dt[l], s5_b_re[l], s5_b_im[l],
                              s5_c_re[l], s5_c_im[l], s5_d[l], s5_w_glu[l], upd_ctx)

        if upd_ctx:
            o_ac = dense_attention(mla_q(cq_c, mla_g_cq[l], mla_w_uq[l], mla_g_qn[l], None), k_ac, v_ac)
            o_bc = swa_context_attention(swa_heads(sq_c, SWA_HEADS, swa_g_qn[l], None), k_bc, v_bc, swa_sink[l])
            mix_c = jnp.concatenate([o_ac * jax.nn.silu(g_mla_c), o_bc * jax.nn.silu(g_swa_c),
                                     o_cc * jax.nn.silu(g_s5_c)], axis=-1)
            ctx_next = ctx + gate_c * (mix_c @ w_out[l])
        mix = jnp.concatenate([o_a * jax.nn.silu(g_mla), o_b * jax.nn.silu(g_swa),
                               o_c * jax.nn.silu(g_s5)], axis=-1)
        x = x + gate * (mix @ w_out[l])
        if upd_ctx:
            ctx = ctx_next
    return x
```

```cpp
#include <hip/hip_runtime.h>
#include <hip/hip_cooperative_groups.h>
#include <cstdio>
namespace cg = cooperative_groups;

#define DI __device__ __forceinline__
typedef unsigned short u16;
typedef __attribute__((ext_vector_type(8))) short bf16x8;
typedef __attribute__((ext_vector_type(16))) float f32x16;
typedef __attribute__((ext_vector_type(2))) float f32x2_t;
typedef __attribute__((ext_vector_type(4))) unsigned u32x4;
typedef __attribute__((ext_vector_type(2))) unsigned u32x2;
typedef __attribute__((ext_vector_type(4))) float f32x4;
typedef __attribute__((ext_vector_type(2))) __bf16 bf16x2_t;
#define MFMA(a, b, c) __builtin_amdgcn_mfma_f32_32x32x16_bf16((a), (b), (c), 0, 0, 0)

constexpr int NB = 8, LAT = 4096, CTXL = 256, SB = 4352, T = NB * SB, DM = 1024;
constexpr int MT = T / 128;
constexpr float EPS = 1e-6f;
constexpr float LOG2E = 1.4426950408889634f;

constexpr size_t SZ_WIN = (size_t)3584 * 1024 * 2, SZ_WOUT = (size_t)1024 * 1536 * 2, SZ_WUQ = (size_t)1024 * 384 * 2,
                 SZ_WUKV = (size_t)1024 * 256 * 2, SZ_WGLU = (size_t)1024 * 512 * 2;
constexpr size_t OFF_WIN = 0;
constexpr size_t OFF_WOUT = OFF_WIN + 4 * SZ_WIN;
constexpr size_t OFF_WUQ = OFF_WOUT + 4 * SZ_WOUT;
constexpr size_t OFF_WUKV = OFF_WUQ + 4 * SZ_WUQ;
constexpr size_t OFF_WGLU = OFF_WUKV + 4 * SZ_WUKV;
constexpr size_t OFF_MOD = OFF_WGLU + 4 * SZ_WGLU;
constexpr size_t OFF_ROPE = OFF_MOD + (size_t)4 * 9 * 3072 * 4;
constexpr size_t OFF_MISC = OFF_ROPE + (size_t)4096 * 96 * 4;
constexpr size_t OFF_CTX = OFF_MISC + 4096;
constexpr size_t OFF_RA = OFF_CTX + (size_t)2048 * 1024 * 4;
constexpr size_t OFF_RB = OFF_RA + (size_t)T * 1024 * 2;
constexpr size_t OFF_G = OFF_RB + (size_t)T * 672 * 2;
constexpr size_t OFF_QB = OFF_G + (size_t)T * 1536 * 2;
constexpr size_t OFF_KB = OFF_QB + (size_t)T * 512 * 2;
constexpr size_t OFF_VTB = OFF_KB + (size_t)T * 128 * 2;
constexpr size_t OFF_U = OFF_VTB + (size_t)T * 128 * 2;
constexpr size_t OFF_QA = OFF_U + (size_t)T * 512 * 2;
constexpr size_t OFF_KA = OFF_QA + (size_t)T * 768 * 2;
constexpr size_t OFF_VTA = OFF_KA + (size_t)T * 768 * 2;
constexpr size_t WS_NEED = OFF_VTA + (size_t)T * 512 * 2;

constexpr int SMEM_BYTES = 67584;

struct Params {
  const float *x, *c, *ctx, *c_ctx, *norm_g, *w_ada, *b_ada, *w_in, *w_out, *g_cq, *g_ckv, *w_uq, *w_ukv, *g_qn, *g_kn,
      *sg_qn, *sg_kn, *sink, *a_re, *a_im, *log_dt, *b_re, *b_im, *c_re, *c_im, *s5d, *w_glu;
  float* out;
  char* ws;
};

DI int opaque_tid() {
  int t = threadIdx.x;
  asm volatile("" : "+v"(t));
  return t;
}
DI unsigned pack2(float a, float b) {
  f32x2_t v = {a, b};
  return __builtin_bit_cast(unsigned, __builtin_convertvector(v, bf16x2_t));
}
DI float bflo(unsigned u) { return __uint_as_float(u << 16); }
DI float bfhi(unsigned u) { return __uint_as_float(u & 0xffff0000u); }
DI float bf1(u16 v) { return __uint_as_float(((unsigned)v) << 16); }
DI int crow(int reg, int h) { return (reg & 3) + 8 * (reg >> 2) + 4 * h; }
DI float silu_f(float x) { return x / (1.f + __expf(-x)); }
DI float sigmoid_f(float x) { return 1.f / (1.f + __expf(-x)); }
DI float gelu_f(float x) {
  float u = 0.7978845608028654f * (x + 0.044715f * x * x * x);
  float e = __expf(2.f * u);
  float th = 1.f - 2.f / (e + 1.f);
  return 0.5f * x * (1.f + th);
}
DI void unpack8(u32x4 v, float* f) {
  f[0] = bflo(v.x); f[1] = bfhi(v.x); f[2] = bflo(v.y); f[3] = bfhi(v.y);
  f[4] = bflo(v.z); f[5] = bfhi(v.z); f[6] = bflo(v.w); f[7] = bfhi(v.w);
}
DI u32x4 pack8(const float* f) {
  u32x4 o;
  o.x = pack2(f[0], f[1]); o.y = pack2(f[2], f[3]); o.z = pack2(f[4], f[5]); o.w = pack2(f[6], f[7]);
  return o;
}
DI bf16x8 as_frag(u32x4 v) { return __builtin_bit_cast(bf16x8, v); }

DI int inv_col(int kind, int np) {
  if (kind == 0) return np;
  if (kind == 1) return np < 672 ? np : (np < 768 ? -1 : np - 96);
  if (kind == 2) { int hd = np >> 7, j = np & 127; return j < 96 ? hd * 96 + j : -1; }
  int blk = np >> 7, j = np & 127;
  return j < 64 ? blk * 64 + j : 512 + blk * 64 + (j - 64);
}

DI void prep_weight_tile(const float* __restrict__ src, int K, int N, u16* __restrict__ dst, int kind,
                         const float* __restrict__ gain, int tile, char* smem) {
  float* sm = (float*)smem;
  const int tid = opaque_tid();
  const int kts = K >> 6;
  const int ntp = tile / kts, kt = tile - ntp * kts;
  const int k0 = kt * 64, n0 = ntp * 64;
  const int nl = tid & 63;
  const int n = inv_col(kind, n0 + nl);
#pragma unroll 4
  for (int i = 0; i < 16; ++i) {
    const int kl = i * 4 + (tid >> 6);
    float v = 0.f;
    if (n >= 0) {
      v = src[(size_t)(k0 + kl) * N + n];
      if (gain) v *= gain[k0 + kl];
    }
    sm[kl * 65 + nl] = v;
  }
  __syncthreads();
#pragma unroll
  for (int j = 0; j < 2; ++j) {
    const int cidx = tid + 256 * j;
    const int nl2 = cidx >> 3, kc = cidx & 7;
    float f[8];
#pragma unroll
    for (int e = 0; e < 8; ++e) f[e] = sm[(kc * 8 + e) * 65 + nl2];
    *(u32x4*)(dst + (size_t)(n0 + nl2) * K + k0 + kc * 8) = pack8(f);
  }
  __syncthreads();
}

DI void adaln_item(const Params& p, int l, int chunk, char* smem) {
  float* ssl = (float*)smem;
  float* red = (float*)(smem + 9 * 1024 * 4);
  const int tid = opaque_tid();
  for (int idx = tid; idx < 9 * 1024; idx += 256) {
    const int j = idx >> 10, k = idx & 1023;
    const float v = j < 8 ? p.c[j * 1024 + k] : p.c_ctx[k];
    ssl[idx] = silu_f(v);
  }
  __syncthreads();
  const int kg = tid >> 6, nl = tid & 63;
  const int n = chunk * 64 + nl;
  float acc[9];
#pragma unroll
  for (int j = 0; j < 9; ++j) acc[j] = 0.f;
  const float* wp = p.w_ada + (size_t)l * 1024 * 3072 + n;
  for (int k = kg * 256; k < kg * 256 + 256; ++k) {
    const float wv = wp[(size_t)k * 3072];
#pragma unroll
    for (int j = 0; j < 9; ++j) acc[j] += ssl[j * 1024 + k] * wv;
  }
#pragma unroll
  for (int j = 0; j < 9; ++j) red[(kg * 9 + j) * 64 + nl] = acc[j];
  __syncthreads();
  float* mod = (float*)(p.ws + OFF_MOD) + (size_t)l * 9 * 3072;
  for (int idx = tid; idx < 9 * 64; idx += 256) {
    const int j = idx >> 6, nl2 = idx & 63;
    const float s = red[(0 * 9 + j) * 64 + nl2] + red[(1 * 9 + j) * 64 + nl2] + red[(2 * 9 + j) * 64 + nl2] +
                    red[(3 * 9 + j) * 64 + nl2];
    mod[j * 3072 + chunk * 64 + nl2] = s + p.b_ada[l * 3072 + chunk * 64 + nl2];
  }
  __syncthreads();
}

DI void rope_item(const Params& p, int item) {
  float* rope = (float*)(p.ws + OFF_ROPE);
  const int t = item * 256 + opaque_tid();
  const float row = (float)(t >> 6), col = (float)(t & 63);
  float* o = rope + (size_t)t * 96;
  for (int j = 0; j < 32; ++j) {
    const float f = powf(10000.f, -(float)(j & 15) / 16.f);
    const float ang = (j < 16 ? row : col) * f;
    o[j] = cosf(ang);
    o[32 + j] = sinf(ang);
  }
  for (int j = 0; j < 16; ++j) {
    const float f = powf(10000.f, -(float)(j & 7) / 8.f);
    const float ang = (j < 8 ? row : col) * f;
    o[64 + j] = cosf(ang);
    o[80 + j] = sinf(ang);
  }
}

DI void misc_item(const Params& p) {
  float* smax = (float*)(p.ws + OFF_MISC);
  int* ctr = (int*)(p.ws + OFF_MISC + 64);
  const int tid = opaque_tid();
  if (tid < 4) {
    const int l = tid;
    float mq = 0.f, mk = 0.f, sq = 0.f, sk = 0.f;
    for (int j = 0; j < 96; ++j) { mq = fmaxf(mq, fabsf(p.g_qn[l * 96 + j])); mk = fmaxf(mk, fabsf(p.g_kn[l * 96 + j])); }
    for (int j = 0; j < 64; ++j) { sq = fmaxf(sq, fabsf(p.sg_qn[l * 64 + j])); sk = fmaxf(sk, fabsf(p.sg_kn[l * 64 + j])); }
    smax[l * 2 + 0] = LOG2E * sqrtf(96.f) * mq * mk;
    smax[l * 2 + 1] = 8.f * sq * sk;
    ctr[l] = 0;
  }
}

DI void phase0(const Params& p, char* smem) {
  constexpr int WPL = 896 + 384 + 96 + 64 + 128;
  const int nitems = 4 * WPL + 192 + 16 + 1;
  for (int it = blockIdx.x; it < nitems; it += gridDim.x) {
    if (it < 4 * WPL) {
      const int l = it / WPL;
      int r = it - l * WPL;
      if (r < 896) {
        prep_weight_tile(p.w_in + (size_t)l * 1024 * 3488, 1024, 3488, (u16*)(p.ws + OFF_WIN + l * SZ_WIN), 1, nullptr, r, smem);
      } else if ((r -= 896) < 384) {
        prep_weight_tile(p.w_out + (size_t)l * 1536 * 1024, 1536, 1024, (u16*)(p.ws + OFF_WOUT + l * SZ_WOUT), 0, nullptr, r, smem);
      } else if ((r -= 384) < 96) {
        prep_weight_tile(p.w_uq + (size_t)l * 384 * 768, 384, 768, (u16*)(p.ws + OFF_WUQ + l * SZ_WUQ), 2, p.g_cq + l * 384, r, smem);
      } else if ((r -= 96) < 64) {
        prep_weight_tile(p.w_ukv + (size_t)l * 256 * 1024, 256, 1024, (u16*)(p.ws + OFF_WUKV + l * SZ_WUKV), 0, p.g_ckv + l * 256, r, smem);
      } else {
        r -= 64;
        prep_weight_tile(p.w_glu + (size_t)l * 512 * 1024, 512, 1024, (u16*)(p.ws + OFF_WGLU + l * SZ_WGLU), 3, nullptr, r, smem);
      }
    } else {
      const int r = it - 4 * WPL;
      if (r < 192) adaln_item(p, r / 48, r % 48, smem);
      else if (r < 208) rope_item(p, r - 192);
      else misc_item(p);
    }
  }
}

DI void phase_norm(const Params& p, int l) {
  const int lane = opaque_tid() & 63, w = opaque_tid() >> 6;
  const float* xs = l == 0 ? p.x : p.out;
  const float* cs = l == 0 ? p.ctx : (const float*)(p.ws + OFF_CTX);
  const float* mod = (const float*)(p.ws + OFF_MOD) + (size_t)l * 9 * 3072;
  const float* ng = p.norm_g + l * 1024;
  u16* xn = (u16*)(p.ws + OFF_RA);
  for (int row = blockIdx.x * 4 + w; row < T; row += gridDim.x * 4) {
    const int b = row / SB, s = row - b * SB;
    const float* src = s < CTXL ? cs + ((size_t)b * CTXL + s) * DM : xs + ((size_t)b * LAT + (s - CTXL)) * DM;
    const float* mr = mod + (s < CTXL ? 8 : b) * 3072;
    f32x4 v[4];
    float ss = 0.f;
#pragma unroll
    for (int i = 0; i < 4; ++i) {
      v[i] = ((const f32x4*)src)[i * 64 + lane];
      ss += v[i].x * v[i].x + v[i].y * v[i].y + v[i].z * v[i].z + v[i].w * v[i].w;
    }
#pragma unroll
    for (int o = 32; o >= 1; o >>= 1) ss += __shfl_xor(ss, o);
    const float rn = rsqrtf(ss * (1.f / 1024.f) + EPS);
#pragma unroll
    for (int i = 0; i < 4; ++i) {
      const int k4 = i * 64 + lane;
      const f32x4 g = ((const f32x4*)ng)[k4];
      const f32x4 sh = ((const f32x4*)mr)[k4];
      const f32x4 sc = ((const f32x4*)(mr + 1024))[k4];
      const float y0 = v[i].x * rn * g.x * (1.f + sc.x) + sh.x;
      const float y1 = v[i].y * rn * g.y * (1.f + sc.y) + sh.y;
      const float y2 = v[i].z * rn * g.z * (1.f + sc.z) + sh.z;
      const float y3 = v[i].w * rn * g.w * (1.f + sc.w) + sh.w;
      u32x2 o2;
      o2.x = pack2(y0, y1);
      o2.y = pack2(y2, y3);
      *(u32x2*)(xn + (size_t)row * DM + k4 * 4) = o2;
    }
  }
}

DI void gemm_tile(const u16* __restrict__ A, int lda, const u16* __restrict__ Bt, int ldb, int K, int m0, int n0,
                  char* smem) {
  u16* As = (u16*)smem;
  u16* Bs = As + 128 * 72;
  float* Cs = (float*)smem;
  const int tid = opaque_tid(), lane = tid & 63, w = tid >> 6, r = lane & 31, h = lane >> 5, wm = w >> 1, wn = w & 1;
  f32x16 acc[2][2];
#pragma unroll
  for (int i = 0; i < 2; ++i)
#pragma unroll
    for (int j = 0; j < 2; ++j)
#pragma unroll
      for (int e = 0; e < 16; ++e) acc[i][j][e] = 0.f;
  const int lrow = tid >> 3, lkc = tid & 7;
  const u16* ap = A + (size_t)(m0 + lrow) * lda + lkc * 8;
  const u16* bp = Bt + (size_t)(n0 + lrow) * ldb + lkc * 8;
  u32x4 ra[4], rb[4];
#pragma unroll
  for (int i = 0; i < 4; ++i) {
    ra[i] = *(const u32x4*)(ap + (size_t)(32 * i) * lda);
    rb[i] = *(const u32x4*)(bp + (size_t)(32 * i) * ldb);
  }
  const int nk = K >> 6;
  for (int kt = 0; kt < nk; ++kt) {
    __syncthreads();
#pragma unroll
    for (int i = 0; i < 4; ++i) {
      *(u32x4*)(As + (lrow + 32 * i) * 72 + lkc * 8) = ra[i];
      *(u32x4*)(Bs + (lrow + 32 * i) * 72 + lkc * 8) = rb[i];
    }
    __syncthreads();
    if (kt + 1 < nk) {
      const int ko = (kt + 1) * 64;
#pragma unroll
      for (int i = 0; i < 4; ++i) {
        ra[i] = *(const u32x4*)(ap + (size_t)(32 * i) * lda + ko);
        rb[i] = *(const u32x4*)(bp + (size_t)(32 * i) * ldb + ko);
      }
    }
#pragma unroll
    for (int s = 0; s < 4; ++s) {
      bf16x8 af[2], bfr[2];
#pragma unroll
      for (int i = 0; i < 2; ++i) af[i] = *(const bf16x8*)(As + (wm * 64 + 32 * i + r) * 72 + 16 * s + 8 * h);
#pragma unroll
      for (int j = 0; j < 2; ++j) bfr[j] = *(const bf16x8*)(Bs + (wn * 64 + 32 * j + r) * 72 + 16 * s + 8 * h);
#pragma unroll
      for (int i = 0; i < 2; ++i)
#pragma unroll
        for (int j = 0; j < 2; ++j) acc[i][j] = MFMA(af[i], bfr[j], acc[i][j]);
    }
  }
  __syncthreads();
#pragma unroll
  for (int i = 0; i < 2; ++i)
#pragma unroll
    for (int j = 0; j < 2; ++j)
#pragma unroll
      for (int e = 0; e < 16; ++e)
        Cs[(wm * 64 + 32 * i + crow(e, h)) * 129 + wn * 64 + 32 * j + r] = acc[i][j][e];
  __syncthreads();
}

DI void p2_store_plain(const float* Cs, u16* dst, int pitch, int m0, int ncols8) {
  const int tid = opaque_tid();
  const int total = 128 * ncols8;
  for (int id = tid; id < total; id += 256) {
    const int row = id / ncols8, c8 = id - row * ncols8;
    float f[8];
#pragma unroll
    for (int e = 0; e < 8; ++e) f[e] = Cs[row * 129 + c8 * 8 + e];
    *(u32x4*)(dst + (size_t)(m0 + row) * pitch + c8 * 8) = pack8(f);
  }
}

DI void p2_store_gate(const float* Cs, u16* dst, int m0) {
  const int tid = opaque_tid();
  for (int id = tid; id < 128 * 16; id += 256) {
    const int row = id >> 4, c8 = id & 15;
    float f[8];
#pragma unroll
    for (int e = 0; e < 8; ++e) f[e] = silu_f(Cs[row * 129 + c8 * 8 + e]);
    *(u32x4*)(dst + (size_t)(m0 + row) * 1536 + c8 * 8) = pack8(f);
  }
}

DI void p2_store_heads(const float* Cs, float* aux, u16* dst, int pitch, int m0, const float* __restrict__ g,
                       const float* __restrict__ rope, float oscale) {
  const int tid = opaque_tid();
  {
    const int row = tid >> 1, hd = tid & 1;
    float ss = 0.f;
    for (int c = 0; c < 64; ++c) { const float v = Cs[row * 129 + hd * 64 + c]; ss += v * v; }
    aux[tid] = rsqrtf(ss * (1.f / 64.f) + EPS);
  }
  __syncthreads();
  const int s0 = m0 % SB;
  const bool lat = s0 >= CTXL;
  for (int id = tid; id < 128 * 16; id += 256) {
    const int row = id >> 4, c8 = id & 15;
    const int hd = c8 >> 3, j0 = (c8 & 7) * 8;
    const float rn = aux[row * 2 + hd];
    const float* cr = Cs + row * 129 + hd * 64;
    float f[8];
    if (lat) {
      const float* rp = rope + (size_t)(s0 + row - CTXL) * 96;
#pragma unroll
      for (int e = 0; e < 8; ++e) {
        const int j = j0 + e, jp = j ^ 32, a = j & 31;
        const float xv = cr[j] * rn * g[j], xp = cr[jp] * rn * g[jp];
        const float cv = rp[a], sv = rp[32 + a];
        f[e] = (j < 32 ? xv * cv - xp * sv : xv * cv + xp * sv) * oscale;
      }
    } else {
#pragma unroll
      for (int e = 0; e < 8; ++e) f[e] = cr[j0 + e] * rn * g[j0 + e] * oscale;
    }
    *(u32x4*)(dst + (size_t)(m0 + row) * pitch + c8 * 8) = pack8(f);
  }
}

DI void store_transposed(const float* Cs, int col0, int ncols, u16* vt_base, int s0, const float* rowscale) {
  const int tid = opaque_tid();
  for (int id = tid; id < ncols * 16; id += 256) {
    const int col = id >> 4, rc = id & 15;
    float f[8];
#pragma unroll
    for (int e = 0; e < 8; ++e) {
      float v = Cs[(rc * 8 + e) * 129 + col0 + col];
      if (rowscale) v *= rowscale[rc * 8 + e];
      f[e] = v;
    }
    *(u32x4*)(vt_base + (size_t)col * SB + s0 + rc * 8) = pack8(f);
  }
}

DI void phase_in(const Params& p, int l, char* smem) {
  const u16* xn = (const u16*)(p.ws + OFF_RA);
  const u16* wt = (const u16*)(p.ws + OFF_WIN + l * SZ_WIN);
  float* Cs = (float*)smem;
  float* aux = (float*)(smem + 66048);
  u16* cq = (u16*)(p.ws + OFF_RB);
  u16* ckv = cq + (size_t)T * 384;
  u16* kr = ckv + (size_t)T * 256;
  u16* G = (u16*)(p.ws + OFF_G);
  u16* qb = (u16*)(p.ws + OFF_QB);
  u16* kb = (u16*)(p.ws + OFF_KB);
  u16* vtb = (u16*)(p.ws + OFF_VTB);
  u16* ub = (u16*)(p.ws + OFF_U);
  const float* rope = (const float*)(p.ws + OFF_ROPE);
  for (int it = blockIdx.x; it < MT * 28; it += gridDim.x) {
    const int mt = it / 28, nt = it - mt * 28;
    const int m0 = mt * 128;
    gemm_tile(xn, 1024, wt, 1024, 1024, m0, nt * 128, smem);
    if (nt < 3) p2_store_plain(Cs, cq + nt * 128, 384, m0, 16);
    else if (nt < 5) p2_store_plain(Cs, ckv + (nt - 3) * 128, 256, m0, 16);
    else if (nt == 5) p2_store_plain(Cs, kr, 32, m0, 4);
    else if (nt < 10) p2_store_gate(Cs, G + (nt - 6) * 128, m0);
    else if (nt < 14) p2_store_heads(Cs, aux, qb + (nt - 10) * 128, 512, m0, p.sg_qn + l * 64, rope, 0.125f * LOG2E);
    else if (nt == 14) p2_store_heads(Cs, aux, kb, 128, m0, p.sg_kn + l * 64, rope, 1.f);
    else if (nt == 15) {
      const int b = m0 / SB, s0 = m0 - b * SB;
      store_transposed(Cs, 0, 128, vtb + (size_t)b * 128 * SB, s0, nullptr);
    } else if (nt < 20) p2_store_gate(Cs, G + 512 + (nt - 16) * 128, m0);
    else if (nt < 24) p2_store_plain(Cs, ub + (nt - 20) * 128, 512, m0, 16);
    else p2_store_gate(Cs, G + 1024 + (nt - 24) * 128, m0);
    __syncthreads();
  }
}

DI void phase_up(const Params& p, int l, char* smem) {
  float* Cs = (float*)smem;
  float* rsA = (float*)(smem + 66048);
  float* rs2 = (float*)(smem + 66048 + 512);
  const u16* cq = (const u16*)(p.ws + OFF_RB);
  const u16* ckv = cq + (size_t)T * 384;
  const u16* kr = ckv + (size_t)T * 256;
  u16* qa = (u16*)(p.ws + OFF_QA);
  u16* ka = (u16*)(p.ws + OFF_KA);
  u16* vta = (u16*)(p.ws + OFF_VTA);
  const float* rope = (const float*)(p.ws + OFF_ROPE);
  const float* gq = p.g_qn + l * 96;
  const float* gk = p.g_kn + l * 96;
  const int tid = opaque_tid();
  const float qscale = 0.10206207261596577f * LOG2E;
  for (int it = blockIdx.x; it < MT * 16; it += gridDim.x) {
    const int mt = it >> 4, sub = it & 15;
    const int isq = sub < 8, hd = sub & 7;
    const int m0 = mt * 128;
    const int b = m0 / SB, s0 = m0 - b * SB;
    const bool lat = s0 >= CTXL;
    if (isq && l == 3 && !lat) continue;
    const u16* A = isq ? cq : ckv;
    const int K = isq ? 384 : 256;
    {
      const int row = tid >> 1, half = tid & 1;
      const u16* ar = A + (size_t)(m0 + row) * K + half * (K >> 1);
      float ss = 0.f;
      for (int c = 0; c < (K >> 4); ++c) {
        float f[8];
        unpack8(*(const u32x4*)(ar + c * 8), f);
#pragma unroll
        for (int e = 0; e < 8; ++e) ss += f[e] * f[e];
      }
      ss += __shfl_xor(ss, 1);
      if (half == 0) rsA[row] = rsqrtf(ss / (float)K + EPS);
    }
    const u16* Bt = isq ? (const u16*)(p.ws + OFF_WUQ + l * SZ_WUQ) + (size_t)hd * 128 * 384
                        : (const u16*)(p.ws + OFF_WUKV + l * SZ_WUKV) + (size_t)hd * 128 * 256;
    gemm_tile(A, K, Bt, K, K, m0, 0, smem);
    if (isq) {
      {
        const int row = tid >> 1, half = tid & 1;
        const float ra = rsA[row];
        float ss = 0.f;
        for (int c = 0; c < 48; ++c) { const float v = Cs[row * 129 + half * 48 + c] * ra; ss += v * v; }
        ss += __shfl_xor(ss, 1);
        if (half == 0) rs2[row] = ra * rsqrtf(ss * (1.f / 96.f) + EPS);
      }
      __syncthreads();
      for (int id = tid; id < 128 * 12; id += 256) {
        const int row = id / 12, c8 = id - row * 12;
        const int j0 = c8 * 8;
        const float sc = rs2[row];
        const float* cr = Cs + row * 129;
        float f[8];
        if (lat && j0 >= 64) {
          const float* rp = rope + (size_t)(s0 + row - CTXL) * 96 + 64;
#pragma unroll
          for (int e = 0; e < 8; ++e) {
            const int i = j0 + e - 64, ip = i ^ 16, a = i & 15;
            const float xv = cr[64 + i] * sc * gq[64 + i], xp = cr[64 + ip] * sc * gq[64 + ip];
            const float cv = rp[a], sv = rp[16 + a];
            f[e] = (i < 16 ? xv * cv - xp * sv : xv * cv + xp * sv) * qscale;
          }
        } else {
#pragma unroll
          for (int e = 0; e < 8; ++e) f[e] = cr[j0 + e] * sc * gq[j0 + e] * qscale;
        }
        *(u32x4*)(qa + (size_t)(m0 + row) * 768 + hd * 96 + j0) = pack8(f);
      }
    } else {
      {
        const int row = tid >> 1, half = tid & 1;
        const float ra = rsA[row];
        float ss = 0.f;
        if (half == 0) {
          for (int c = 0; c < 64; ++c) { const float v = Cs[row * 129 + c] * ra; ss += v * v; }
        } else {
          const u16* kp = kr + (size_t)(m0 + row) * 32;
          for (int c = 0; c < 4; ++c) {
            float f[8];
            unpack8(*(const u32x4*)(kp + c * 8), f);
#pragma unroll
            for (int e = 0; e < 8; ++e) ss += f[e] * f[e];
          }
        }
        ss += __shfl_xor(ss, 1);
        if (half == 0) rs2[row] = rsqrtf(ss * (1.f / 96.f) + EPS);
      }
      __syncthreads();
      for (int id = tid; id < 128 * 12; id += 256) {
        const int row = id / 12, c8 = id - row * 12;
        const int j0 = c8 * 8;
        const float rn = rs2[row];
        float f[8];
        if (j0 < 64) {
          const float sc = rn * rsA[row];
#pragma unroll
          for (int e = 0; e < 8; ++e) f[e] = Cs[row * 129 + j0 + e] * sc * gk[j0 + e];
        } else {
          const u16* kp = kr + (size_t)(m0 + row) * 32;
          const int i0 = j0 - 64;
          if (lat) {
            const float* rp = rope + (size_t)(s0 + row - CTXL) * 96 + 64;
#pragma unroll
            for (int e = 0; e < 8; ++e) {
              const int i = i0 + e, ip = i ^ 16, a = i & 15;
              const float xv = bf1(kp[i]) * rn * gk[64 + i], xp = bf1(kp[ip]) * rn * gk[64 + ip];
              const float cv = rp[a], sv = rp[16 + a];
              f[e] = i < 16 ? xv * cv - xp * sv : xv * cv + xp * sv;
            }
          } else {
#pragma unroll
            for (int e = 0; e < 8; ++e) f[e] = bf1(kp[i0 + e]) * rn * gk[64 + i0 + e];
          }
        }
        *(u32x4*)(ka + (size_t)(m0 + row) * 768 + hd * 96 + j0) = pack8(f);
      }
      store_transposed(Cs, 64, 64, vta + ((size_t)(b * 8 + hd) * 64) * SB, s0, rsA);
    }
    __syncthreads();
  }
}

DI void s5_unit(const Params& p, int l, int unit, char* smem) {
  const int b = unit >> 5, g = unit & 31;
  const int tid = opaque_tid(), lane = tid & 63, w = tid >> 6, r = lane & 31, h = lane >> 5;
  const u16* ub = (const u16*)(p.ws + OFF_U);
  u16* yfb = (u16*)(p.ws + OFF_RA);
  if (w < 2) {
    const int dir = w;
    float* BU = (float*)(smem + w * 27648);
    u16* Hb = (u16*)(smem + w * 27648 + 16384);
    float* Yt = (float*)(smem + w * 27648 + 16384 + 8704);
    u16* yout = yfb + (size_t)dir * T * 512;
    const int pidx = (l * 2 + dir) * 32 + g;
    const float dt = expf(p.log_dt[pidx]);
    float abr, abi;
    {
      const float are = p.a_re[pidx * 64 + lane], aim = p.a_im[pidx * 64 + lane];
      const float ex = expf(dt * are), y = dt * aim;
      abr = ex * cosf(y);
      abi = ex * sinf(y);
    }
    bf16x8 bfr[4];
#pragma unroll
    for (int half = 0; half < 2; ++half) {
      const int nn = r + 32 * half;
      const float are = p.a_re[pidx * 64 + nn], aim = p.a_im[pidx * 64 + nn];
      const float x = dt * are, y = dt * aim, ex = expf(x), sy = sinf(y), cy = cosf(y), sh2 = sinf(0.5f * y);
      const float nre = expm1f(x) * cy - 2.f * sh2 * sh2, nim = ex * sy;
      const float den = 1.f / (are * are + aim * aim);
      const float cre = (nre * are + nim * aim) * den, cim = (nim * are - nre * aim) * den;
      const float* bre = p.b_re + ((size_t)pidx * 64 + nn) * 16 + 8 * h;
      const float* bim = p.b_im + ((size_t)pidx * 64 + nn) * 16 + 8 * h;
      float vre[8], vim[8];
#pragma unroll
      for (int j = 0; j < 8; ++j) {
        const float br = bre[j], bi = bim[j];
        vre[j] = cre * br - cim * bi;
        vim[j] = cre * bi + cim * br;
      }
      bfr[half] = as_frag(pack8(vre));
      bfr[2 + half] = as_frag(pack8(vim));
    }
    bf16x8 cfr[8];
#pragma unroll
    for (int s = 0; s < 8; ++s) {
      float cv[8];
#pragma unroll
      for (int j = 0; j < 8; ++j) {
        const int k = 16 * s + 8 * h + j, n = k >> 1;
        float v = 0.f;
        if (r < 16) {
          const size_t ci = ((size_t)pidx * 16 + r) * 64 + n;
          v = (k & 1) ? -p.c_im[ci] : p.c_re[ci];
        }
        cv[j] = v;
      }
      cfr[s] = as_frag(pack8(cv));
    }
    float hre = 0.f, him = 0.f;
    f32x16 zero;
#pragma unroll
    for (int e = 0; e < 16; ++e) zero[e] = 0.f;
    auto rowbase_of = [&](int jt) {
      const int j0 = jt * 32;
      return dir == 0 ? j0 : (j0 < CTXL ? 224 - j0 : 4576 - j0);
    };
    const u16* ucol = ub + (size_t)b * SB * 512 + g * 16 + 8 * h;
    u32x4 ucur = *(const u32x4*)(ucol + (size_t)(rowbase_of(0) + r) * 512);
    for (int jt = 0; jt < 136; ++jt) {
      const int rowbase = rowbase_of(jt);
      const bf16x8 ua = as_frag(ucur);
      if (jt + 1 < 136) ucur = *(const u32x4*)(ucol + (size_t)(rowbase_of(jt + 1) + r) * 512);
#pragma unroll
      for (int nt = 0; nt < 4; ++nt) {
        const f32x16 d = MFMA(ua, bfr[nt], zero);
#pragma unroll
        for (int e = 0; e < 16; ++e) BU[((nt >> 1) * 32 + crow(e, h)) * 64 + (nt & 1) * 32 + r] = d[e];
      }
#pragma unroll 8
      for (int i = 0; i < 32; ++i) {
        const int t = dir ? 31 - i : i;
        const float bre = BU[t * 64 + lane], bim = BU[(32 + t) * 64 + lane];
        const float nre = abr * hre - abi * him + bre;
        const float nim = abr * him + abi * hre + bim;
        hre = nre;
        him = nim;
        *(unsigned*)(Hb + t * 136 + 2 * lane) = pack2(hre, him);
      }
      f32x16 y = zero;
#pragma unroll
      for (int s = 0; s < 8; ++s) {
        const bf16x8 a = *(const bf16x8*)(Hb + r * 136 + 16 * s + 8 * h);
        y = MFMA(a, cfr[s], y);
      }
      if (r < 16) {
#pragma unroll
        for (int e = 0; e < 16; ++e) Yt[crow(e, h) * 17 + r] = y[e];
      }
      {
        const int t = lane >> 1, half = lane & 1;
        float f[8];
#pragma unroll
        for (int e = 0; e < 8; ++e) f[e] = Yt[t * 17 + half * 8 + e];
        *(u32x4*)(yout + ((size_t)b * SB + rowbase + t) * 512 + g * 16 + half * 8) = pack8(f);
      }
    }
  }
  __syncthreads();
  {
    const float* dv = p.s5d + l * 512 + g * 16;
    u16* yg = (u16*)(p.ws + OFF_RB);
    const u16* yf = yfb;
    const u16* yb = yfb + (size_t)T * 512;
    for (int id = tid; id < SB * 2; id += 256) {
      const int row = id >> 1, half = id & 1;
      const size_t off = ((size_t)b * SB + row) * 512 + g * 16 + half * 8;
      float a[8], c[8], uu[8], f[8];
      unpack8(*(const u32x4*)(yf + off), a);
      unpack8(*(const u32x4*)(yb + off), c);
      unpack8(*(const u32x4*)(ub + off), uu);
#pragma unroll
      for (int e = 0; e < 8; ++e) f[e] = gelu_f(dv[half * 8 + e] * uu[e] + a[e] + c[e]);
      *(u32x4*)(yg + off) = pack8(f);
    }
  }
  __syncthreads();
}

template <int DQK, bool SWA>
DI void attn_item(const u16* __restrict__ Qh, int qpitch, const u16* __restrict__ Kh, int kpitch,
                  const u16* __restrict__ Vt, int b, int q0, int nt1, int lo2, int nt2, float c2, float extra,
                  u16* __restrict__ Gh, char* smem) {
  constexpr int KP = DQK + 8, NS = DQK / 16, CH = DQK / 8, KCH = (64 * CH) / 256;
  u16* Ks = (u16*)smem;
  u16* Vs = Ks + 64 * KP;
  const int tid = opaque_tid(), lane = tid & 63, w = tid >> 6, r = lane & 31, h = lane >> 5;
  const size_t rowb = (size_t)b * SB;
  bf16x8 qf[NS];
  {
    const u16* qp = Qh + (rowb + q0 + 32 * w + r) * qpitch + 8 * h;
#pragma unroll
    for (int s = 0; s < NS; ++s) qf[s] = *(const bf16x8*)(qp + 16 * s);
  }
  f32x16 O[2];
#pragma unroll
  for (int d = 0; d < 2; ++d)
#pragma unroll
    for (int e = 0; e < 16; ++e) O[d][e] = 0.f;
  float lsum = 0.f;
  const int ntiles = nt1 + nt2;
  u32x4 rk[KCH], rv[2];
#define KSTART_OF(ti) ((ti) < nt1 ? (ti) * 64 : lo2 + ((ti) - nt1) * 64)
#define LOAD_TILE(ks0_)                                                                  \
  {                                                                                      \
    _Pragma("unroll") for (int i = 0; i < KCH; ++i) {                                    \
      const int id = tid + 256 * i;                                                      \
      const int krow = id / CH, kc = id - krow * CH;                                     \
      rk[i] = *(const u32x4*)(Kh + (rowb + (ks0_) + krow) * kpitch + kc * 8);            \
    }                                                                                    \
    _Pragma("unroll") for (int i = 0; i < 2; ++i) {                                      \
      const int id = tid + 256 * i;                                                      \
      const int dv = id >> 3, kc = id & 7;                                               \
      rv[i] = *(const u32x4*)(Vt + (size_t)dv * SB + (ks0_) + kc * 8);                   \
    }                                                                                    \
  }
  LOAD_TILE(KSTART_OF(0));
  const int qr = q0 + 32 * w + r;
  for (int ti = 0; ti < ntiles; ++ti) {
    const int ks0 = KSTART_OF(ti);
    __syncthreads();
#pragma unroll
    for (int i = 0; i < KCH; ++i) {
      const int id = tid + 256 * i;
      const int krow = id / CH, kc = id - krow * CH;
      *(u32x4*)(Ks + krow * KP + kc * 8) = rk[i];
    }
#pragma unroll
    for (int i = 0; i < 2; ++i) {
      const int id = tid + 256 * i;
      const int dv = id >> 3, kc = id & 7;
      u32x2 lo, hi;
      lo.x = rv[i].x; lo.y = rv[i].y; hi.x = rv[i].z; hi.y = rv[i].w;
      *(u32x2*)(Vs + dv * 68 + kc * 8) = lo;
      *(u32x2*)(Vs + dv * 68 + kc * 8 + 4) = hi;
    }
    __syncthreads();
    if (ti + 1 < ntiles) LOAD_TILE(KSTART_OF(ti + 1));
    f32x16 S[2];
#pragma unroll
    for (int kb = 0; kb < 2; ++kb) {
#pragma unroll
      for (int e = 0; e < 16; ++e) S[kb][e] = 0.f;
#pragma unroll
      for (int s = 0; s < NS; ++s) {
        const bf16x8 a = *(const bf16x8*)(Ks + (32 * kb + r) * KP + 16 * s + 8 * h);
        S[kb] = MFMA(a, qf[s], S[kb]);
      }
    }
    const bool masked = SWA && ti >= nt1;
    bf16x8 pf[4];
#pragma unroll
    for (int kb = 0; kb < 2; ++kb) {
      float pv[16];
#pragma unroll
      for (int e = 0; e < 16; ++e) {
        float pe = __builtin_amdgcn_exp2f(S[kb][e] - c2);
        if (masked) {
          const int kr = ks0 + 32 * kb + crow(e, h);
          const int d = qr - kr;
          pe = (d <= 128 && d >= -128) ? pe : 0.f;
        }
        lsum += pe;
        pv[e] = pe;
      }
      pf[2 * kb] = as_frag(pack8(pv));
      pf[2 * kb + 1] = as_frag(pack8(pv + 8));
    }
#pragma unroll
    for (int dt = 0; dt < 2; ++dt) {
#pragma unroll
      for (int ks = 0; ks < 4; ++ks) {
        const u16* vp = Vs + (32 * dt + r) * 68 + 16 * ks + 4 * h;
        const u32x2 lo = *(const u32x2*)vp;
        const u32x2 hi = *(const u32x2*)(vp + 8);
        u32x4 av;
        av.x = lo.x; av.y = lo.y; av.z = hi.x; av.w = hi.y;
        O[dt] = MFMA(as_frag(av), pf[ks], O[dt]);
      }
    }
  }
  const float ltot = lsum + __shfl_xor(lsum, 32) + extra;
  const float inv = 1.f / ltot;
  u16* gp = Gh + (rowb + q0 + 32 * w + r) * 1536;
#pragma unroll
  for (int dt = 0; dt < 2; ++dt) {
#pragma unroll
    for (int gq = 0; gq < 4; ++gq) {
      const int dv = 32 * dt + 8 * gq + 4 * h;
      const u32x2 gv = *(const u32x2*)(gp + dv);
      u32x2 ov;
      ov.x = pack2(O[dt][4 * gq + 0] * inv * bflo(gv.x), O[dt][4 * gq + 1] * inv * bfhi(gv.x));
      ov.y = pack2(O[dt][4 * gq + 2] * inv * bflo(gv.y), O[dt][4 * gq + 3] * inv * bfhi(gv.y));
      *(u32x2*)(gp + dv) = ov;
    }
  }
}

DI void phase_mix(const Params& p, int l, char* smem, int* s_item) {
  for (int unit = blockIdx.x; unit < 256; unit += gridDim.x) s5_unit(p, l, unit, smem);
  int* ctr = (int*)(p.ws + OFF_MISC + 64) + l;
  const float* smax = (const float*)(p.ws + OFF_MISC);
  const u16* qa = (const u16*)(p.ws + OFF_QA);
  const u16* ka = (const u16*)(p.ws + OFF_KA);
  const u16* vta = (const u16*)(p.ws + OFF_VTA);
  const u16* qb = (const u16*)(p.ws + OFF_QB);
  const u16* kb = (const u16*)(p.ws + OFF_KB);
  const u16* vtb = (const u16*)(p.ws + OFF_VTB);
  u16* G = (u16*)(p.ws + OFF_G);
  const int NIT = 2 * 8 * 8 * 34;
  for (;;) {
    __syncthreads();
    if (opaque_tid() == 0) *s_item = atomicAdd(ctr, 1);
    __syncthreads();
    const int it = *s_item;
    if (it >= NIT) break;
    const int kind = it / 2176;
    const int r = it - kind * 2176;
    const int qt = 33 - (r >> 6);
    const int bh = r & 63;
    const int b = bh >> 3, hd = bh & 7;
    const int q0 = qt * 128;
    const bool lat = qt >= 2;
    if (l == 3 && !lat) continue;
    if (kind == 0) {
      attn_item<96, false>(qa + hd * 96, 768, ka + hd * 96, 768, vta + ((size_t)(b * 8 + hd) * 64) * SB, b, q0,
                           lat ? 68 : 4, 0, 0, smax[l * 2], 0.f, G + hd * 64, smem);
    } else {
      const int kvh = hd >> 2;
      const float sk = p.sink[l * 8 + hd];
      const float M = fmaxf(smax[l * 2 + 1], sk);
      const float c2 = M * LOG2E;
      const float extra = exp2f(sk * LOG2E - c2);
      int lo2 = 0, nt2 = 0;
      if (lat) {
        lo2 = max(CTXL, q0 - 128);
        const int hi2 = min(SB, q0 + 256);
        nt2 = (hi2 - lo2) >> 6;
      }
      attn_item<64, true>(qb + hd * 64, 512, kb + kvh * 64, 128, vtb + ((size_t)(b * 2 + kvh) * 64) * SB, b, q0, 4,
                          lo2, nt2, c2, extra, G + 512 + hd * 64, smem);
    }
  }
}

DI void phase_glu(const Params& p, int l, char* smem) {
  const u16* yg = (const u16*)(p.ws + OFF_RB);
  const u16* wt = (const u16*)(p.ws + OFF_WGLU + l * SZ_WGLU);
  u16* G = (u16*)(p.ws + OFF_G);
  const float* Cs = (const float*)smem;
  const int tid = opaque_tid();
  for (int it = blockIdx.x; it < MT * 8; it += gridDim.x) {
    const int mt = it >> 3, nt = it & 7;
    if (l == 3 && (mt % 34) < 2) continue;
    const int m0 = mt * 128;
    gemm_tile(yg, 512, wt, 512, 512, m0, nt * 128, smem);
    for (int id = tid; id < 128 * 8; id += 256) {
      const int row = id >> 3, c8 = id & 7;
      u16* gp = G + (size_t)(m0 + row) * 1536 + 1024 + nt * 64 + c8 * 8;
      float gv[8], f[8];
      unpack8(*(const u32x4*)gp, gv);
#pragma unroll
      for (int e = 0; e < 8; ++e) {
        const float za = Cs[row * 129 + c8 * 8 + e], zb = Cs[row * 129 + 64 + c8 * 8 + e];
        f[e] = za * sigmoid_f(zb) * gv[e];
      }
      *(u32x4*)gp = pack8(f);
    }
    __syncthreads();
  }
}

DI void phase_out(const Params& p, int l, char* smem) {
  const u16* G = (const u16*)(p.ws + OFF_G);
  const u16* wt = (const u16*)(p.ws + OFF_WOUT + l * SZ_WOUT);
  const float* Cs = (const float*)smem;
  const float* mod = (const float*)(p.ws + OFF_MOD) + (size_t)l * 9 * 3072;
  const float* xs = l == 0 ? p.x : p.out;
  const float* cs = l == 0 ? p.ctx : (const float*)(p.ws + OFF_CTX);
  float* cd = (float*)(p.ws + OFF_CTX);
  const int tid = opaque_tid();
  for (int it = blockIdx.x; it < MT * 8; it += gridDim.x) {
    const int mt = it >> 3, nt = it & 7;
    if (l == 3 && (mt % 34) < 2) continue;
    const int m0 = mt * 128;
    const int b = m0 / SB, s0 = m0 - b * SB;
    const bool lat = s0 >= CTXL;
    gemm_tile(G, 1536, wt, 1536, 1536, m0, nt * 128, smem);
    const float* gate = mod + (lat ? b : 8) * 3072 + 2048 + nt * 128;
    for (int id = tid; id < 128 * 32; id += 256) {
      const int row = id >> 5, c4 = id & 31;
      const size_t ro = lat ? ((size_t)b * LAT + (s0 + row - CTXL)) * DM : ((size_t)b * CTXL + s0 + row) * DM;
      const float* sp = (lat ? xs : cs) + ro + nt * 128 + c4 * 4;
      float* dp = (lat ? p.out : cd) + ro + nt * 128 + c4 * 4;
      const f32x4 xo = *(const f32x4*)sp;
      const f32x4 gt = *(const f32x4*)(gate + c4 * 4);
      const float* cr = Cs + row * 129 + c4 * 4;
      f32x4 o;
      o.x = xo.x + gt.x * cr[0];
      o.y = xo.y + gt.y * cr[1];
      o.z = xo.z + gt.z * cr[2];
      o.w = xo.w + gt.w * cr[3];
      *(f32x4*)dp = o;
    }
    __syncthreads();
  }
}

__global__ void __launch_bounds__(256, 2) hybrid_fwd(Params p) {
  __shared__ __attribute__((aligned(16))) char smem[SMEM_BYTES];
  __shared__ int s_item;
  cg::grid_group grid = cg::this_grid();
  phase0(p, smem);
  grid.sync();
  for (int l = 0; l < 4; ++l) {
    phase_norm(p, l);
    grid.sync();
    phase_in(p, l, smem);
    grid.sync();
    phase_up(p, l, smem);
    grid.sync();
    phase_mix(p, l, smem, &s_item);
    grid.sync();
    phase_glu(p, l, smem);
    grid.sync();
    phase_out(p, l, smem);
    if (l < 3) grid.sync();
  }
}

extern "C" void kernel_launch(void* const* d_in, const int* in_sizes, int n_in, void* d_out, int out_size, void* d_ws,
                              size_t ws_size, hipStream_t stream) {
  static int grid_blocks = 0;
  if (!grid_blocks) {
    int dev = 0, cus = 0, per_cu = 0;
    hipGetDevice(&dev);
    hipDeviceGetAttribute(&cus, hipDeviceAttributeMultiprocessorCount, dev);
    hipOccupancyMaxActiveBlocksPerMultiprocessor(&per_cu, hybrid_fwd, 256, 0);
    if (per_cu > 2) per_cu = 2;
    grid_blocks = cus * per_cu;
  }
  if (ws_size < WS_NEED || grid_blocks <= 0) {
    fprintf(stderr, "workspace too small or no occupancy: %zu < %zu, grid %d\n", ws_size, (size_t)WS_NEED, grid_blocks);
    return;
  }
  Params p{};
  const float** pp = (const float**)&p;
  for (int i = 0; i < 27; ++i) pp[i] = (const float*)d_in[i];
  p.out = (float*)d_out;
  p.ws = (char*)d_ws;
  void* args[] = {&p};
  hipError_t e = hipLaunchCooperativeKernel((void*)hybrid_fwd, dim3(grid_blocks), dim3(256), args, 0, stream);
  if (e != hipSuccess) fprintf(stderr, "cooperative launch failed: %s (grid %d)\n", hipGetErrorString(e), grid_blocks);
}
```

```cpp
#include <hip/hip_runtime.h>
#include <hip/hip_cooperative_groups.h>
#include <cstdio>
namespace cg = cooperative_groups;

#define DI __device__ __forceinline__
typedef unsigned short u16;
typedef __attribute__((ext_vector_type(8))) short bf16x8;
typedef __attribute__((ext_vector_type(16))) float f32x16;
typedef __attribute__((ext_vector_type(2))) float f32x2_t;
typedef __attribute__((ext_vector_type(4))) unsigned u32x4;
typedef __attribute__((ext_vector_type(2))) unsigned u32x2;
typedef __attribute__((ext_vector_type(4))) float f32x4;
typedef __attribute__((ext_vector_type(2))) __bf16 bf16x2_t;
#define MFMA(a, b, c) __builtin_amdgcn_mfma_f32_32x32x16_bf16((a), (b), (c), 0, 0, 0)

constexpr int NB = 8, LAT = 4096, CTXL = 256, SB = 4352, T = NB * SB, DM = 1024;
constexpr int MT = T / 128;
constexpr float EPS = 1e-6f;
constexpr float LOG2E = 1.4426950408889634f;

constexpr size_t SZ_WIN = (size_t)3584 * 1024 * 2, SZ_WOUT = (size_t)1024 * 1536 * 2, SZ_WUQ = (size_t)1024 * 384 * 2,
                 SZ_WUKV = (size_t)1024 * 256 * 2, SZ_WGLU = (size_t)1024 * 512 * 2;
constexpr size_t OFF_WIN = 0;
constexpr size_t OFF_WOUT = OFF_WIN + 4 * SZ_WIN;
constexpr size_t OFF_WUQ = OFF_WOUT + 4 * SZ_WOUT;
constexpr size_t OFF_WUKV = OFF_WUQ + 4 * SZ_WUQ;
constexpr size_t OFF_WGLU = OFF_WUKV + 4 * SZ_WUKV;
constexpr size_t OFF_MOD = OFF_WGLU + 4 * SZ_WGLU;
constexpr size_t OFF_ROPE = OFF_MOD + (size_t)4 * 9 * 3072 * 4;
constexpr size_t OFF_MISC = OFF_ROPE + (size_t)4096 * 96 * 4;
constexpr size_t MISC_BYTES = 32768;
constexpr size_t OFF_CTX = OFF_MISC + MISC_BYTES;
constexpr size_t OFF_RA = OFF_CTX + (size_t)2048 * 1024 * 4;
constexpr size_t OFF_RB = OFF_RA + (size_t)T * 1024 * 2;
constexpr size_t OFF_G = OFF_RB + (size_t)T * 672 * 2;
constexpr size_t OFF_QB = OFF_G + (size_t)T * 1536 * 2;
constexpr size_t OFF_KB = OFF_QB + (size_t)T * 512 * 2;
constexpr size_t OFF_VTB = OFF_KB + (size_t)T * 128 * 2;
constexpr size_t OFF_U = OFF_VTB + (size_t)T * 128 * 2;
constexpr size_t OFF_QA = OFF_U + (size_t)T * 512 * 2;
constexpr size_t OFF_KA = OFF_QA + (size_t)T * 768 * 2;
constexpr size_t OFF_VTA = OFF_KA + (size_t)T * 768 * 2;
constexpr size_t WS_NEED = OFF_VTA + (size_t)T * 512 * 2;

#ifndef REP_GEMM
#define REP_GEMM 1
#endif
#ifndef REP_ATTN
#define REP_ATTN 1
#endif
#ifndef REP_S5
#define REP_S5 2
#endif
constexpr int SMEM_BYTES = 67584;

struct Params {
  const float *x, *c, *ctx, *c_ctx, *norm_g, *w_ada, *b_ada, *w_in, *w_out, *g_cq, *g_ckv, *w_uq, *w_ukv, *g_qn, *g_kn,
      *sg_qn, *sg_kn, *sink, *a_re, *a_im, *log_dt, *b_re, *b_im, *c_re, *c_im, *s5d, *w_glu;
  float* out;
  char* ws;
};

DI int opaque_tid() {
  int t = threadIdx.x;
  asm volatile("" : "+v"(t));
  return t;
}
DI unsigned pack2(float a, float b) {
  f32x2_t v = {a, b};
  return __builtin_bit_cast(unsigned, __builtin_convertvector(v, bf16x2_t));
}
DI float bflo(unsigned u) { return __uint_as_float(u << 16); }
DI float bfhi(unsigned u) { return __uint_as_float(u & 0xffff0000u); }
DI float bf1(u16 v) { return __uint_as_float(((unsigned)v) << 16); }
DI int crow(int reg, int h) { return (reg & 3) + 8 * (reg >> 2) + 4 * h; }
DI float silu_f(float x) { return x / (1.f + __expf(-x)); }
DI float sigmoid_f(float x) { return 1.f / (1.f + __expf(-x)); }
DI float gelu_f(float x) {
  float u = 0.7978845608028654f * (x + 0.044715f * x * x * x);
  float e = __expf(2.f * u);
  float th = 1.f - 2.f / (e + 1.f);
  return 0.5f * x * (1.f + th);
}
DI void unpack8(u32x4 v, float* f) {
  f[0] = bflo(v.x); f[1] = bfhi(v.x); f[2] = bflo(v.y); f[3] = bfhi(v.y);
  f[4] = bflo(v.z); f[5] = bfhi(v.z); f[6] = bflo(v.w); f[7] = bfhi(v.w);
}
DI u32x4 pack8(const float* f) {
  u32x4 o;
  o.x = pack2(f[0], f[1]); o.y = pack2(f[2], f[3]); o.z = pack2(f[4], f[5]); o.w = pack2(f[6], f[7]);
  return o;
}
DI bf16x8 as_frag(u32x4 v) { return __builtin_bit_cast(bf16x8, v); }


#define XB_TMO 128
#define XB_XCNT(j) (256 + 64 * (j))
#define XB_XSUB(j) (1280 + 64 * (j))
#define XB_XGEN(j) (2304 + 64 * (j))
#define XB_TOP 3328
#define XB_TOPGEN 3392
#define XCD_BAR_WORDS 3456
#define XB_SPIN_CAP (1u << 22)
#define LAS __attribute__((address_space(3)))
DI unsigned xb_ld(unsigned* p) { return __hip_atomic_load(p, __ATOMIC_RELAXED, __HIP_MEMORY_SCOPE_AGENT); }
DI unsigned xb_add(unsigned* p, unsigned v) { return __hip_atomic_fetch_add(p, v, __ATOMIC_RELAXED, __HIP_MEMORY_SCOPE_AGENT); }
DI unsigned xb_xcc_id() { return (unsigned)__builtin_amdgcn_s_getreg((3 << 11) | 20) & 0xFu; }
#define XB_SPIN(cond, bar)                                                             \
  do {                                                                                 \
    unsigned _sp = 0;                                                                  \
    while (cond) {                                                                     \
      __builtin_amdgcn_s_sleep(1);                                                     \
      if ((++_sp & 255u) == 0u) {                                                      \
        if (xb_ld(&(bar)[XB_TMO])) break;                                              \
        if (_sp > XB_SPIN_CAP) { atomicAdd(&(bar)[XB_TMO], 1u); break; }               \
      }                                                                                \
    }                                                                                  \
  } while (0)
struct XcdBarrier {
  unsigned* bar;
  unsigned x;
  volatile LAS unsigned* st;
};
DI XcdBarrier xcd_barrier_post(unsigned* bar, volatile LAS unsigned* st) {
  XcdBarrier b;
  b.bar = bar;
  b.x = xb_xcc_id();
  b.st = st;
  if (threadIdx.x == 0) (void)xb_add(&bar[XB_XCNT(b.x)], 1u);
  return b;
}
DI void xcd_barrier_complete(unsigned* bar, unsigned x, unsigned& nloc, unsigned& nx) {
  const unsigned G = gridDim.x * gridDim.y * gridDim.z;
  unsigned sum, cnt, mine, sp = 0u;
  for (;;) {
    sum = 0u; cnt = 0u; mine = 0u;
#pragma unroll
    for (unsigned j = 0; j < 16; ++j) {
      const unsigned c = xb_ld(&bar[XB_XCNT(j)]);
      sum += c;
      cnt += (c > 0u) ? 1u : 0u;
      mine = (j == x) ? c : mine;
    }
    if (sum == G) break;
    __builtin_amdgcn_s_sleep(1);
    if ((++sp & 255u) == 0u) {
      if (xb_ld(&bar[XB_TMO])) break;
      if (sp > XB_SPIN_CAP) { atomicAdd(&bar[XB_TMO], 1u); break; }
    }
  }
  nloc = mine > 0u ? mine : 1u;
  nx = cnt > 0u ? cnt : 1u;
}
DI void xcd_barrier(const XcdBarrier& b) {
  asm volatile("s_waitcnt vmcnt(0)" ::: "memory");
  __syncthreads();
  if (threadIdx.x == 0) {
    unsigned* bar = b.bar;
    __builtin_amdgcn_s_waitcnt(0);
    unsigned nloc = b.st[0], nx = b.st[1];
    if (nloc == 0u) {
      xcd_barrier_complete(bar, b.x, nloc, nx);
      b.st[0] = nloc;
      b.st[1] = nx;
    }
    const unsigned old = xb_add(&bar[XB_XSUB(b.x)], 1u);
    const unsigned gen = old / nloc;
    if (old + 1u == (gen + 1u) * nloc) {
      __builtin_amdgcn_fence(__ATOMIC_RELEASE, "agent");
      asm volatile("s_waitcnt vmcnt(0)" ::: "memory");
      const unsigned og = xb_add(&bar[XB_TOP], 1u);
      const unsigned tg = og / nx;
      if (og + 1u == (tg + 1u) * nx) xb_add(&bar[XB_TOPGEN], 1u);
      else XB_SPIN(xb_ld(&bar[XB_TOPGEN]) == tg, bar);
      __builtin_amdgcn_fence(__ATOMIC_ACQUIRE, "agent");
      xb_add(&bar[XB_XGEN(b.x)], 1u);
      asm volatile("s_waitcnt vmcnt(0)" ::: "memory");
    } else {
      XB_SPIN(xb_ld(&bar[XB_XGEN(b.x)]) == gen, bar);
      __builtin_amdgcn_fence(__ATOMIC_ACQUIRE, "agent");
      asm volatile("s_waitcnt vmcnt(0)" ::: "memory");
    }
  }
  __syncthreads();
}

DI int inv_col(int kind, int np) {
  if (kind == 0) return np;
  if (kind == 1) return np < 672 ? np : (np < 768 ? -1 : np - 96);
  if (kind == 2) { int hd = np >> 7, j = np & 127; return j < 96 ? hd * 96 + j : -1; }
  int blk = np >> 7, j = np & 127;
  return j < 64 ? blk * 64 + j : 512 + blk * 64 + (j - 64);
}

DI void prep_weight_tile(const float* __restrict__ src, int K, int N, u16* __restrict__ dst, int kind,
                         const float* __restrict__ gain, int tile, char* smem) {
  float* sm = (float*)smem;
  const int tid = opaque_tid();
  const int kts = K >> 6;
  const int ntp = tile / kts, kt = tile - ntp * kts;
  const int k0 = kt * 64, n0 = ntp * 64;
  const int nl = tid & 63;
  const int n = inv_col(kind, n0 + nl);
#pragma unroll 4
  for (int i = 0; i < 16; ++i) {
    const int kl = i * 4 + (tid >> 6);
    float v = 0.f;
    if (n >= 0) {
      v = src[(size_t)(k0 + kl) * N + n];
      if (gain) v *= gain[k0 + kl];
    }
    sm[kl * 65 + nl] = v;
  }
  __syncthreads();
#pragma unroll
  for (int j = 0; j < 2; ++j) {
    const int cidx = tid + 256 * j;
    const int nl2 = cidx >> 3, kc = cidx & 7;
    float f[8];
#pragma unroll
    for (int e = 0; e < 8; ++e) f[e] = sm[(kc * 8 + e) * 65 + nl2];
    *(u32x4*)(dst + (size_t)(n0 + nl2) * K + k0 + kc * 8) = pack8(f);
  }
  __syncthreads();
}

DI void adaln_item(const Params& p, int l, int chunk, char* smem) {
  float* ssl = (float*)smem;
  float* red = (float*)(smem + 9 * 1024 * 4);
  const int tid = opaque_tid();
  for (int idx = tid; idx < 9 * 1024; idx += 256) {
    const int j = idx >> 10, k = idx & 1023;
    const float v = j < 8 ? p.c[j * 1024 + k] : p.c_ctx[k];
    ssl[idx] = silu_f(v);
  }
  __syncthreads();
  const int kg = tid >> 6, nl = tid & 63;
  const int n = chunk * 64 + nl;
  float acc[9];
#pragma unroll
  for (int j = 0; j < 9; ++j) acc[j] = 0.f;
  const float* wp = p.w_ada + (size_t)l * 1024 * 3072 + n;
  for (int k = kg * 256; k < kg * 256 + 256; ++k) {
    const float wv = wp[(size_t)k * 3072];
#pragma unroll
    for (int j = 0; j < 9; ++j) acc[j] += ssl[j * 1024 + k] * wv;
  }
#pragma unroll
  for (int j = 0; j < 9; ++j) red[(kg * 9 + j) * 64 + nl] = acc[j];
  __syncthreads();
  float* mod = (float*)(p.ws + OFF_MOD) + (size_t)l * 9 * 3072;
  for (int idx = tid; idx < 9 * 64; idx += 256) {
    const int j = idx >> 6, nl2 = idx & 63;
    const float s = red[(0 * 9 + j) * 64 + nl2] + red[(1 * 9 + j) * 64 + nl2] + red[(2 * 9 + j) * 64 + nl2] +
                    red[(3 * 9 + j) * 64 + nl2];
    mod[j * 3072 + chunk * 64 + nl2] = s + p.b_ada[l * 3072 + chunk * 64 + nl2];
  }
  __syncthreads();
}

DI void rope_item(const Params& p, int item) {
  float* rope = (float*)(p.ws + OFF_ROPE);
  const int t = item * 256 + opaque_tid();
  const float row = (float)(t >> 6), col = (float)(t & 63);
  float* o = rope + (size_t)t * 96;
  for (int j = 0; j < 32; ++j) {
    const float f = powf(10000.f, -(float)(j & 15) / 16.f);
    const float ang = (j < 16 ? row : col) * f;
    o[j] = cosf(ang);
    o[32 + j] = sinf(ang);
  }
  for (int j = 0; j < 16; ++j) {
    const float f = powf(10000.f, -(float)(j & 7) / 8.f);
    const float ang = (j < 8 ? row : col) * f;
    o[64 + j] = cosf(ang);
    o[80 + j] = sinf(ang);
  }
}

DI void misc_item(const Params& p) {
  float* smax = (float*)(p.ws + OFF_MISC);
  const int tid = opaque_tid();
  if (tid < 4) {
    const int l = tid;
    float mq = 0.f, mk = 0.f, sq = 0.f, sk = 0.f;
    for (int j = 0; j < 96; ++j) { mq = fmaxf(mq, fabsf(p.g_qn[l * 96 + j])); mk = fmaxf(mk, fabsf(p.g_kn[l * 96 + j])); }
    for (int j = 0; j < 64; ++j) { sq = fmaxf(sq, fabsf(p.sg_qn[l * 64 + j])); sk = fmaxf(sk, fabsf(p.sg_kn[l * 64 + j])); }
    smax[l * 2 + 0] = LOG2E * sqrtf(96.f) * mq * mk;
    smax[l * 2 + 1] = 8.f * sq * sk;
  }
}

DI void phase0(const Params& p, char* smem) {
  constexpr int WPL = 896 + 384 + 96 + 64 + 128;
  const int nitems = 4 * WPL + 192 + 16 + 1;
  for (int it = blockIdx.x; it < nitems; it += gridDim.x) {
    if (it < 4 * WPL) {
      const int l = it / WPL;
      int r = it - l * WPL;
      if (r < 896) {
        prep_weight_tile(p.w_in + (size_t)l * 1024 * 3488, 1024, 3488, (u16*)(p.ws + OFF_WIN + l * SZ_WIN), 1, nullptr, r, smem);
      } else if ((r -= 896) < 384) {
        prep_weight_tile(p.w_out + (size_t)l * 1536 * 1024, 1536, 1024, (u16*)(p.ws + OFF_WOUT + l * SZ_WOUT), 0, nullptr, r, smem);
      } else if ((r -= 384) < 96) {
        prep_weight_tile(p.w_uq + (size_t)l * 384 * 768, 384, 768, (u16*)(p.ws + OFF_WUQ + l * SZ_WUQ), 2, p.g_cq + l * 384, r, smem);
      } else if ((r -= 96) < 64) {
        prep_weight_tile(p.w_ukv + (size_t)l * 256 * 1024, 256, 1024, (u16*)(p.ws + OFF_WUKV + l * SZ_WUKV), 0, p.g_ckv + l * 256, r, smem);
      } else {
        r -= 64;
        prep_weight_tile(p.w_glu + (size_t)l * 512 * 1024, 512, 1024, (u16*)(p.ws + OFF_WGLU + l * SZ_WGLU), 3, nullptr, r, smem);
      }
    } else {
      const int r = it - 4 * WPL;
      if (r < 192) adaln_item(p, r / 48, r % 48, smem);
      else if (r < 208) rope_item(p, r - 192);
      else misc_item(p);
    }
  }
}

DI void phase_norm(const Params& p, int l) {
  const int lane = opaque_tid() & 63, w = opaque_tid() >> 6;
  const float* xs = l == 0 ? p.x : p.out;
  const float* cs = l == 0 ? p.ctx : (const float*)(p.ws + OFF_CTX);
  const float* mod = (const float*)(p.ws + OFF_MOD) + (size_t)l * 9 * 3072;
  const float* ng = p.norm_g + l * 1024;
  u16* xn = (u16*)(p.ws + OFF_RA);
  const int grp = blockIdx.x & 7, lb = blockIdx.x >> 3, nlb = gridDim.x >> 3;
  for (int q = lb * 4 + w; q < 34 * 128; q += nlb * 4) {
    const int row = (grp + 8 * (q >> 7)) * 128 + (q & 127);
    const int b = row / SB, s = row - b * SB;
    const float* src = s < CTXL ? cs + ((size_t)b * CTXL + s) * DM : xs + ((size_t)b * LAT + (s - CTXL)) * DM;
    const float* mr = mod + (s < CTXL ? 8 : b) * 3072;
    f32x4 v[4];
    float ss = 0.f;
#pragma unroll
    for (int i = 0; i < 4; ++i) {
      v[i] = ((const f32x4*)src)[i * 64 + lane];
      ss += v[i].x * v[i].x + v[i].y * v[i].y + v[i].z * v[i].z + v[i].w * v[i].w;
    }
#pragma unroll
    for (int o = 32; o >= 1; o >>= 1) ss += __shfl_xor(ss, o);
    const float rn = rsqrtf(ss * (1.f / 1024.f) + EPS);
#pragma unroll
    for (int i = 0; i < 4; ++i) {
      const int k4 = i * 64 + lane;
      const f32x4 g = ((const f32x4*)ng)[k4];
      const f32x4 sh = ((const f32x4*)mr)[k4];
      const f32x4 sc = ((const f32x4*)(mr + 1024))[k4];
      const float y0 = v[i].x * rn * g.x * (1.f + sc.x) + sh.x;
      const float y1 = v[i].y * rn * g.y * (1.f + sc.y) + sh.y;
      const float y2 = v[i].z * rn * g.z * (1.f + sc.z) + sh.z;
      const float y3 = v[i].w * rn * g.w * (1.f + sc.w) + sh.w;
      u32x2 o2;
      o2.x = pack2(y0, y1);
      o2.y = pack2(y2, y3);
      *(u32x2*)(xn + (size_t)row * DM + k4 * 4) = o2;
    }
  }
}

DI void gemm_tile(const u16* __restrict__ A, int lda, const u16* __restrict__ Bt, int ldb, int K, int m0, int n0,
                  char* smem) {
  u16* As = (u16*)smem;
  u16* Bs = As + 128 * 72;
  float* Cs = (float*)smem;
  const int tid = opaque_tid(), lane = tid & 63, w = tid >> 6, r = lane & 31, h = lane >> 5, wm = w >> 1, wn = w & 1;
  f32x16 acc[2][2];
#pragma unroll
  for (int i = 0; i < 2; ++i)
#pragma unroll
    for (int j = 0; j < 2; ++j)
#pragma unroll
      for (int e = 0; e < 16; ++e) acc[i][j][e] = 0.f;
  const int lrow = tid >> 3, lkc = tid & 7;
  const u16* ap = A + (size_t)(m0 + lrow) * lda + lkc * 8;
  const u16* bp = Bt + (size_t)(n0 + lrow) * ldb + lkc * 8;
  u32x4 ra[4], rb[4];
  const int nk = K >> 6;
  for (int rep = 0; rep < REP_GEMM; ++rep) {
#pragma unroll
  for (int i = 0; i < 4; ++i) {
    ra[i] = *(const u32x4*)(ap + (size_t)(32 * i) * lda);
    rb[i] = *(const u32x4*)(bp + (size_t)(32 * i) * ldb);
  }
  for (int kt = 0; kt < nk; ++kt) {
    __syncthreads();
#pragma unroll
    for (int i = 0; i < 4; ++i) {
      *(u32x4*)(As + (lrow + 32 * i) * 72 + lkc * 8) = ra[i];
      *(u32x4*)(Bs + (lrow + 32 * i) * 72 + lkc * 8) = rb[i];
    }
    __syncthreads();
    if (kt + 1 < nk) {
      const int ko = (kt + 1) * 64;
#pragma unroll
      for (int i = 0; i < 4; ++i) {
        ra[i] = *(const u32x4*)(ap + (size_t)(32 * i) * lda + ko);
        rb[i] = *(const u32x4*)(bp + (size_t)(32 * i) * ldb + ko);
      }
    }
#pragma unroll
    for (int s = 0; s < 4; ++s) {
      bf16x8 af[2], bfr[2];
#pragma unroll
      for (int i = 0; i < 2; ++i) af[i] = *(const bf16x8*)(As + (wm * 64 + 32 * i + r) * 72 + 16 * s + 8 * h);
#pragma unroll
      for (int j = 0; j < 2; ++j) bfr[j] = *(const bf16x8*)(Bs + (wn * 64 + 32 * j + r) * 72 + 16 * s + 8 * h);
#pragma unroll
      for (int i = 0; i < 2; ++i)
#pragma unroll
        for (int j = 0; j < 2; ++j) acc[i][j] = MFMA(af[i], bfr[j], acc[i][j]);
    }
  }
  }
  __syncthreads();
#pragma unroll
  for (int i = 0; i < 2; ++i)
#pragma unroll
    for (int j = 0; j < 2; ++j)
#pragma unroll
      for (int e = 0; e < 16; ++e)
        Cs[(wm * 64 + 32 * i + crow(e, h)) * 129 + wn * 64 + 32 * j + r] = acc[i][j][e] * (1.f / REP_GEMM);
  __syncthreads();
}

DI void p2_store_plain(const float* Cs, u16* dst, int pitch, int m0, int ncols8) {
  const int tid = opaque_tid();
  const int total = 128 * ncols8;
  for (int id = tid; id < total; id += 256) {
    const int row = id / ncols8, c8 = id - row * ncols8;
    float f[8];
#pragma unroll
    for (int e = 0; e < 8; ++e) f[e] = Cs[row * 129 + c8 * 8 + e];
    *(u32x4*)(dst + (size_t)(m0 + row) * pitch + c8 * 8) = pack8(f);
  }
}

DI void p2_store_gate(const float* Cs, u16* dst, int m0) {
  const int tid = opaque_tid();
  for (int id = tid; id < 128 * 16; id += 256) {
    const int row = id >> 4, c8 = id & 15;
    float f[8];
#pragma unroll
    for (int e = 0; e < 8; ++e) f[e] = silu_f(Cs[row * 129 + c8 * 8 + e]);
    *(u32x4*)(dst + (size_t)(m0 + row) * 1536 + c8 * 8) = pack8(f);
  }
}

DI void p2_store_heads(const float* Cs, float* aux, u16* dst, int pitch, int m0, const float* __restrict__ g,
                       const float* __restrict__ rope, float oscale) {
  const int tid = opaque_tid();
  {
    const int row = tid >> 1, hd = tid & 1;
    float ss = 0.f;
    for (int c = 0; c < 64; ++c) { const float v = Cs[row * 129 + hd * 64 + c]; ss += v * v; }
    aux[tid] = rsqrtf(ss * (1.f / 64.f) + EPS);
  }
  __syncthreads();
  const int s0 = m0 % SB;
  const bool lat = s0 >= CTXL;
  for (int id = tid; id < 128 * 16; id += 256) {
    const int row = id >> 4, c8 = id & 15;
    const int hd = c8 >> 3, j0 = (c8 & 7) * 8;
    const float rn = aux[row * 2 + hd];
    const float* cr = Cs + row * 129 + hd * 64;
    float f[8];
    if (lat) {
      const float* rp = rope + (size_t)(s0 + row - CTXL) * 96;
#pragma unroll
      for (int e = 0; e < 8; ++e) {
        const int j = j0 + e, jp = j ^ 32, a = j & 31;
        const float xv = cr[j] * rn * g[j], xp = cr[jp] * rn * g[jp];
        const float cv = rp[a], sv = rp[32 + a];
        f[e] = (j < 32 ? xv * cv - xp * sv : xv * cv + xp * sv) * oscale;
      }
    } else {
#pragma unroll
      for (int e = 0; e < 8; ++e) f[e] = cr[j0 + e] * rn * g[j0 + e] * oscale;
    }
    *(u32x4*)(dst + (size_t)(m0 + row) * pitch + c8 * 8) = pack8(f);
  }
}

DI void store_transposed(const float* Cs, int col0, int ncols, u16* vt_base, int s0, const float* rowscale) {
  const int tid = opaque_tid();
  for (int id = tid; id < ncols * 16; id += 256) {
    const int col = id >> 4, rc = id & 15;
    float f[8];
#pragma unroll
    for (int e = 0; e < 8; ++e) {
      float v = Cs[(rc * 8 + e) * 129 + col0 + col];
      if (rowscale) v *= rowscale[rc * 8 + e];
      f[e] = v;
    }
    *(u32x4*)(vt_base + (size_t)col * SB + s0 + rc * 8) = pack8(f);
  }
}

DI void phase_in(const Params& p, int l, char* smem) {
  const u16* xn = (const u16*)(p.ws + OFF_RA);
  const u16* wt = (const u16*)(p.ws + OFF_WIN + l * SZ_WIN);
  float* Cs = (float*)smem;
  float* aux = (float*)(smem + 66048);
  u16* cq = (u16*)(p.ws + OFF_RB);
  u16* ckv = cq + (size_t)T * 384;
  u16* kr = ckv + (size_t)T * 256;
  u16* G = (u16*)(p.ws + OFF_G);
  u16* qb = (u16*)(p.ws + OFF_QB);
  u16* kb = (u16*)(p.ws + OFF_KB);
  u16* vtb = (u16*)(p.ws + OFF_VTB);
  u16* ub = (u16*)(p.ws + OFF_U);
  const float* rope = (const float*)(p.ws + OFF_ROPE);
  const int grp = blockIdx.x & 7, lb = blockIdx.x >> 3, nlb = gridDim.x >> 3;
  for (int j = lb; j < 34 * 28; j += nlb) {
    int mi, nt;
    if (j < 896) { const int sr = j / 224, rem = j - sr * 224; mi = sr * 8 + (rem & 7); nt = rem >> 3; }
    else { const int rem = j - 896; mi = 32 + (rem & 1); nt = rem >> 1; }
    const int mt = grp + 8 * mi;
    const int m0 = mt * 128;
    gemm_tile(xn, 1024, wt, 1024, 1024, m0, nt * 128, smem);
    if (nt < 3) p2_store_plain(Cs, cq + nt * 128, 384, m0, 16);
    else if (nt < 5) p2_store_plain(Cs, ckv + (nt - 3) * 128, 256, m0, 16);
    else if (nt == 5) p2_store_plain(Cs, kr, 32, m0, 4);
    else if (nt < 10) p2_store_gate(Cs, G + (nt - 6) * 128, m0);
    else if (nt < 14) p2_store_heads(Cs, aux, qb + (nt - 10) * 128, 512, m0, p.sg_qn + l * 64, rope, 0.125f * LOG2E);
    else if (nt == 14) p2_store_heads(Cs, aux, kb, 128, m0, p.sg_kn + l * 64, rope, 1.f);
    else if (nt == 15) {
      const int b = m0 / SB, s0 = m0 - b * SB;
      store_transposed(Cs, 0, 128, vtb + (size_t)b * 128 * SB, s0, nullptr);
    } else if (nt < 20) p2_store_gate(Cs, G + 512 + (nt - 16) * 128, m0);
    else if (nt < 24) p2_store_plain(Cs, ub + (nt - 20) * 128, 512, m0, 16);
    else p2_store_gate(Cs, G + 1024 + (nt - 24) * 128, m0);
    __syncthreads();
  }
}

DI void phase_up(const Params& p, int l, char* smem) {
  float* Cs = (float*)smem;
  float* rsA = (float*)(smem + 66048);
  float* rs2 = (float*)(smem + 66048 + 512);
  const u16* cq = (const u16*)(p.ws + OFF_RB);
  const u16* ckv = cq + (size_t)T * 384;
  const u16* kr = ckv + (size_t)T * 256;
  u16* qa = (u16*)(p.ws + OFF_QA);
  u16* ka = (u16*)(p.ws + OFF_KA);
  u16* vta = (u16*)(p.ws + OFF_VTA);
  const float* rope = (const float*)(p.ws + OFF_ROPE);
  const float* gq = p.g_qn + l * 96;
  const float* gk = p.g_kn + l * 96;
  const int tid = opaque_tid();
  const float qscale = 0.10206207261596577f * LOG2E;
  const int grp = blockIdx.x & 7, lb = blockIdx.x >> 3, nlb = gridDim.x >> 3;
  for (int j = lb; j < 34 * 16; j += nlb) {
    const int mt = grp + 8 * (j >> 4), sub = j & 15;
    const int isq = sub < 8, hd = sub & 7;
    const int m0 = mt * 128;
    const int b = m0 / SB, s0 = m0 - b * SB;
    const bool lat = s0 >= CTXL;
    if (isq && l == 3 && !lat) continue;
    const u16* A = isq ? cq : ckv;
    const int K = isq ? 384 : 256;
    {
      const int row = tid >> 1, half = tid & 1;
      const u16* ar = A + (size_t)(m0 + row) * K + half * (K >> 1);
      float ss = 0.f;
      for (int c = 0; c < (K >> 4); ++c) {
        float f[8];
        unpack8(*(const u32x4*)(ar + c * 8), f);
#pragma unroll
        for (int e = 0; e < 8; ++e) ss += f[e] * f[e];
      }
      ss += __shfl_xor(ss, 1);
      if (half == 0) rsA[row] = rsqrtf(ss / (float)K + EPS);
    }
    const u16* Bt = isq ? (const u16*)(p.ws + OFF_WUQ + l * SZ_WUQ) + (size_t)hd * 128 * 384
                        : (const u16*)(p.ws + OFF_WUKV + l * SZ_WUKV) + (size_t)hd * 128 * 256;
    gemm_tile(A, K, Bt, K, K, m0, 0, smem);
    if (isq) {
      {
        const int row = tid >> 1, half = tid & 1;
        const float ra = rsA[row];
        float ss = 0.f;
        for (int c = 0; c < 48; ++c) { const float v = Cs[row * 129 + half * 48 + c] * ra; ss += v * v; }
        ss += __shfl_xor(ss, 1);
        if (half == 0) rs2[row] = ra * rsqrtf(ss * (1.f / 96.f) + EPS);
      }
      __syncthreads();
      for (int id = tid; id < 128 * 12; id += 256) {
        const int row = id / 12, c8 = id - row * 12;
        const int j0 = c8 * 8;
        const float sc = rs2[row];
        const float* cr = Cs + row * 129;
        float f[8];
        if (lat && j0 >= 64) {
          const float* rp = rope + (size_t)(s0 + row - CTXL) * 96 + 64;
#pragma unroll
          for (int e = 0; e < 8; ++e) {
            const int i = j0 + e - 64, ip = i ^ 16, a = i & 15;
            const float xv = cr[64 + i] * sc * gq[64 + i], xp = cr[64 + ip] * sc * gq[64 + ip];
            const float cv = rp[a], sv = rp[16 + a];
            f[e] = (i < 16 ? xv * cv - xp * sv : xv * cv + xp * sv) * qscale;
          }
        } else {
#pragma unroll
          for (int e = 0; e < 8; ++e) f[e] = cr[j0 + e] * sc * gq[j0 + e] * qscale;
        }
        *(u32x4*)(qa + (size_t)(m0 + row) * 768 + hd * 96 + j0) = pack8(f);
      }
    } else {
      {
        const int row = tid >> 1, half = tid & 1;
        const float ra = rsA[row];
        float ss = 0.f;
        if (half == 0) {
          for (int c = 0; c < 64; ++c) { const float v = Cs[row * 129 + c] * ra; ss += v * v; }
        } else {
          const u16* kp = kr + (size_t)(m0 + row) * 32;
          for (int c = 0; c < 4; ++c) {
            float f[8];
            unpack8(*(const u32x4*)(kp + c * 8), f);
#pragma unroll
            for (int e = 0; e < 8; ++e) ss += f[e] * f[e];
          }
        }
        ss += __shfl_xor(ss, 1);
        if (half == 0) rs2[row] = rsqrtf(ss * (1.f / 96.f) + EPS);
      }
      __syncthreads();
      for (int id = tid; id < 128 * 12; id += 256) {
        const int row = id / 12, c8 = id - row * 12;
        const int j0 = c8 * 8;
        const float rn = rs2[row];
        float f[8];
        if (j0 < 64) {
          const float sc = rn * rsA[row];
#pragma unroll
          for (int e = 0; e < 8; ++e) f[e] = Cs[row * 129 + j0 + e] * sc * gk[j0 + e];
        } else {
          const u16* kp = kr + (size_t)(m0 + row) * 32;
          const int i0 = j0 - 64;
          if (lat) {
            const float* rp = rope + (size_t)(s0 + row - CTXL) * 96 + 64;
#pragma unroll
            for (int e = 0; e < 8; ++e) {
              const int i = i0 + e, ip = i ^ 16, a = i & 15;
              const float xv = bf1(kp[i]) * rn * gk[64 + i], xp = bf1(kp[ip]) * rn * gk[64 + ip];
              const float cv = rp[a], sv = rp[16 + a];
              f[e] = i < 16 ? xv * cv - xp * sv : xv * cv + xp * sv;
            }
          } else {
#pragma unroll
            for (int e = 0; e < 8; ++e) f[e] = bf1(kp[i0 + e]) * rn * gk[64 + i0 + e];
          }
        }
        *(u32x4*)(ka + (size_t)(m0 + row) * 768 + hd * 96 + j0) = pack8(f);
      }
      store_transposed(Cs, 64, 64, vta + ((size_t)(b * 8 + hd) * 64) * SB, s0, rsA);
    }
    __syncthreads();
  }
}

DI void s5_unit(const Params& p, int l, int unit, char* smem) {
  const int b = unit >> 5, g = unit & 31;
  const int tid = opaque_tid(), lane = tid & 63, w = tid >> 6, r = lane & 31, h = lane >> 5;
  const u16* ub = (const u16*)(p.ws + OFF_U);
  u16* yfb = (u16*)(p.ws + OFF_RA);
  if (w < 2) {
    const int dir = w;
    float* BU = (float*)(smem + w * 27648);
    u16* Hb = (u16*)(smem + w * 27648 + 16384);
    float* Yt = (float*)(smem + w * 27648 + 16384 + 8704);
    u16* yout = yfb + (size_t)dir * T * 512;
    const int pidx = (l * 2 + dir) * 32 + g;
    const float dt = expf(p.log_dt[pidx]);
    float abr, abi;
    {
      const float are = p.a_re[pidx * 64 + lane], aim = p.a_im[pidx * 64 + lane];
      const float ex = expf(dt * are), y = dt * aim;
      abr = ex * cosf(y);
      abi = ex * sinf(y);
    }
    bf16x8 bfr[4];
#pragma unroll
    for (int half = 0; half < 2; ++half) {
      const int nn = r + 32 * half;
      const float are = p.a_re[pidx * 64 + nn], aim = p.a_im[pidx * 64 + nn];
      const float x = dt * are, y = dt * aim, ex = expf(x), sy = sinf(y), cy = cosf(y), sh2 = sinf(0.5f * y);
      const float nre = expm1f(x) * cy - 2.f * sh2 * sh2, nim = ex * sy;
      const float den = 1.f / (are * are + aim * aim);
      const float cre = (nre * are + nim * aim) * den, cim = (nim * are - nre * aim) * den;
      const float* bre = p.b_re + ((size_t)pidx * 64 + nn) * 16 + 8 * h;
      const float* bim = p.b_im + ((size_t)pidx * 64 + nn) * 16 + 8 * h;
      float vre[8], vim[8];
#pragma unroll
      for (int j = 0; j < 8; ++j) {
        const float br = bre[j], bi = bim[j];
        vre[j] = cre * br - cim * bi;
        vim[j] = cre * bi + cim * br;
      }
      bfr[half] = as_frag(pack8(vre));
      bfr[2 + half] = as_frag(pack8(vim));
    }
    bf16x8 cfr[8];
#pragma unroll
    for (int s = 0; s < 8; ++s) {
      float cv[8];
#pragma unroll
      for (int j = 0; j < 8; ++j) {
        const int k = 16 * s + 8 * h + j, n = k >> 1;
        float v = 0.f;
        if (r < 16) {
          const size_t ci = ((size_t)pidx * 16 + r) * 64 + n;
          v = (k & 1) ? -p.c_im[ci] : p.c_re[ci];
        }
        cv[j] = v;
      }
      cfr[s] = as_frag(pack8(cv));
    }
    float hre = 0.f, him = 0.f;
    f32x16 zero;
#pragma unroll
    for (int e = 0; e < 16; ++e) zero[e] = 0.f;
    auto rowbase_of = [&](int jt) {
      const int j0 = jt * 32;
      return dir == 0 ? j0 : (j0 < CTXL ? 224 - j0 : 4576 - j0);
    };
    const u16* ucol = ub + (size_t)b * SB * 512 + g * 16 + 8 * h;
    u32x4 ucur = *(const u32x4*)(ucol + (size_t)(rowbase_of(0) + r) * 512);
    for (int jt = 0; jt < 136; ++jt) {
      const int rowbase = rowbase_of(jt);
      const bf16x8 ua = as_frag(ucur);
      if (jt + 1 < 136) ucur = *(const u32x4*)(ucol + (size_t)(rowbase_of(jt + 1) + r) * 512);
#pragma unroll
      for (int nt = 0; nt < 4; ++nt) {
        const f32x16 d = MFMA(ua, bfr[nt], zero);
#pragma unroll
        for (int e = 0; e < 16; ++e) BU[((nt >> 1) * 32 + crow(e, h)) * 64 + (nt & 1) * 32 + r] = d[e];
      }
#pragma unroll 8
      for (int i = 0; i < 32; ++i) {
        const int t = dir ? 31 - i : i;
        const float bre = BU[t * 64 + lane], bim = BU[(32 + t) * 64 + lane];
        const float nre = abr * hre - abi * him + bre;
        const float nim = abr * him + abi * hre + bim;
        hre = nre;
        him = nim;
        *(unsigned*)(Hb + t * 136 + 2 * lane) = pack2(hre, him);
      }
      f32x16 y = zero;
#pragma unroll
      for (int s = 0; s < 8; ++s) {
        const bf16x8 a = *(const bf16x8*)(Hb + r * 136 + 16 * s + 8 * h);
        y = MFMA(a, cfr[s], y);
      }
      if (r < 16) {
#pragma unroll
        for (int e = 0; e < 16; ++e) Yt[crow(e, h) * 17 + r] = y[e];
      }
      {
        const int t = lane >> 1, half = lane & 1;
        float f[8];
#pragma unroll
        for (int e = 0; e < 8; ++e) f[e] = Yt[t * 17 + half * 8 + e];
        *(u32x4*)(yout + ((size_t)b * SB + rowbase + t) * 512 + g * 16 + half * 8) = pack8(f);
      }
    }
  }
  __syncthreads();
  {
    const float* dv = p.s5d + l * 512 + g * 16;
    u16* yg = (u16*)(p.ws + OFF_RB);
    const u16* yf = yfb;
    const u16* yb = yfb + (size_t)T * 512;
    for (int id = tid; id < SB * 2; id += 256) {
      const int row = id >> 1, half = id & 1;
      const size_t off = ((size_t)b * SB + row) * 512 + g * 16 + half * 8;
      float a[8], c[8], uu[8], f[8];
      unpack8(*(const u32x4*)(yf + off), a);
      unpack8(*(const u32x4*)(yb + off), c);
      unpack8(*(const u32x4*)(ub + off), uu);
#pragma unroll
      for (int e = 0; e < 8; ++e) f[e] = gelu_f(dv[half * 8 + e] * uu[e] + a[e] + c[e]);
      *(u32x4*)(yg + off) = pack8(f);
    }
  }
  __syncthreads();
}

template <int DQK, bool SWA>
DI void attn_item(const u16* __restrict__ Qh, int qpitch, const u16* __restrict__ Kh, int kpitch,
                  const u16* __restrict__ Vt, int b, int q0, int nt1, int lo2, int nt2, float c2, float extra,
                  u16* __restrict__ Gh, char* smem) {
  constexpr int KP = DQK + 8, NS = DQK / 16, CH = DQK / 8, KCH = (64 * CH) / 256;
  u16* Ks = (u16*)smem;
  u16* Vs = Ks + 64 * KP;
  const int tid = opaque_tid(), lane = tid & 63, w = tid >> 6, r = lane & 31, h = lane >> 5;
  const size_t rowb = (size_t)b * SB;
  bf16x8 qf[NS];
  {
    const u16* qp = Qh + (rowb + q0 + 32 * w + r) * qpitch + 8 * h;
#pragma unroll
    for (int s = 0; s < NS; ++s) qf[s] = *(const bf16x8*)(qp + 16 * s);
  }
  f32x16 O[2];
#pragma unroll
  for (int d = 0; d < 2; ++d)
#pragma unroll
    for (int e = 0; e < 16; ++e) O[d][e] = 0.f;
  float lsum = 0.f;
  const int ntiles = nt1 + nt2;
  u32x4 rk[KCH], rv[2];
#define KSTART_OF(ti) ((ti) < nt1 ? (ti) * 64 : lo2 + ((ti) - nt1) * 64)
#define LOAD_TILE(ks0_)                                                                  \
  {                                                                                      \
    _Pragma("unroll") for (int i = 0; i < KCH; ++i) {                                    \
      const int id = tid + 256 * i;                                                      \
      const int krow = id / CH, kc = id - krow * CH;                                     \
      rk[i] = *(const u32x4*)(Kh + (rowb + (ks0_) + krow) * kpitch + kc * 8);            \
    }                                                                                    \
    _Pragma("unroll") for (int i = 0; i < 2; ++i) {                                      \
      const int id = tid + 256 * i;                                                      \
      const int dv = id >> 3, kc = id & 7;                                               \
      rv[i] = *(const u32x4*)(Vt + (size_t)dv * SB + (ks0_) + kc * 8);                   \
    }                                                                                    \
  }
  const int qr = q0 + 32 * w + r;
  for (int rep = 0; rep < REP_ATTN; ++rep) {
  LOAD_TILE(KSTART_OF(0));
  for (int ti = 0; ti < ntiles; ++ti) {
    const int ks0 = KSTART_OF(ti);
    __syncthreads();
#pragma unroll
    for (int i = 0; i < KCH; ++i) {
      const int id = tid + 256 * i;
      const int krow = id / CH, kc = id - krow * CH;
      *(u32x4*)(Ks + krow * KP + kc * 8) = rk[i];
    }
#pragma unroll
    for (int i = 0; i < 2; ++i) {
      const int id = tid + 256 * i;
      const int dv = id >> 3, kc = id & 7;
      u32x2 lo, hi;
      lo.x = rv[i].x; lo.y = rv[i].y; hi.x = rv[i].z; hi.y = rv[i].w;
      *(u32x2*)(Vs + dv * 68 + kc * 8) = lo;
      *(u32x2*)(Vs + dv * 68 + kc * 8 + 4) = hi;
    }
    __syncthreads();
    if (ti + 1 < ntiles) LOAD_TILE(KSTART_OF(ti + 1));
    f32x16 S[2];
#pragma unroll
    for (int kb = 0; kb < 2; ++kb) {
#pragma unroll
      for (int e = 0; e < 16; ++e) S[kb][e] = 0.f;
#pragma unroll
      for (int s = 0; s < NS; ++s) {
        const bf16x8 a = *(const bf16x8*)(Ks + (32 * kb + r) * KP + 16 * s + 8 * h);
        S[kb] = MFMA(a, qf[s], S[kb]);
      }
    }
    const bool masked = SWA && ti >= nt1;
    bf16x8 pf[4];
#pragma unroll
    for (int kb = 0; kb < 2; ++kb) {
      float pv[16];
#pragma unroll
      for (int e = 0; e < 16; ++e) {
        float pe = __builtin_amdgcn_exp2f(S[kb][e] - c2);
        if (masked) {
          const int kr = ks0 + 32 * kb + crow(e, h);
          const int d = qr - kr;
          pe = (d <= 128 && d >= -128) ? pe : 0.f;
        }
        lsum += pe;
        pv[e] = pe;
      }
      pf[2 * kb] = as_frag(pack8(pv));
      pf[2 * kb + 1] = as_frag(pack8(pv + 8));
    }
#pragma unroll
    for (int dt = 0; dt < 2; ++dt) {
#pragma unroll
      for (int ks = 0; ks < 4; ++ks) {
        const u16* vp = Vs + (32 * dt + r) * 68 + 16 * ks + 4 * h;
        const u32x2 lo = *(const u32x2*)vp;
        const u32x2 hi = *(const u32x2*)(vp + 8);
        u32x4 av;
        av.x = lo.x; av.y = lo.y; av.z = hi.x; av.w = hi.y;
        O[dt] = MFMA(as_frag(av), pf[ks], O[dt]);
      }
    }
  }
  }
  const float ltot = lsum + __shfl_xor(lsum, 32) + extra * REP_ATTN;
  const float inv = 1.f / ltot;
  u16* gp = Gh + (rowb + q0 + 32 * w + r) * 1536;
#pragma unroll
  for (int dt = 0; dt < 2; ++dt) {
#pragma unroll
    for (int gq = 0; gq < 4; ++gq) {
      const int dv = 32 * dt + 8 * gq + 4 * h;
      const u32x2 gv = *(const u32x2*)(gp + dv);
      u32x2 ov;
      ov.x = pack2(O[dt][4 * gq + 0] * inv * bflo(gv.x), O[dt][4 * gq + 1] * inv * bfhi(gv.x));
      ov.y = pack2(O[dt][4 * gq + 2] * inv * bflo(gv.y), O[dt][4 * gq + 3] * inv * bfhi(gv.y));
      *(u32x2*)(gp + dv) = ov;
    }
  }
}

DI void phase_mix(const Params& p, int l, char* smem, int* s_item) {
  for (int rep = 0; rep < REP_S5; ++rep)
    for (int unit = blockIdx.x; unit < 256; unit += gridDim.x) s5_unit(p, l, unit, smem);
  const int grp = blockIdx.x & 7;
  int* ctr = (int*)(p.ws + OFF_MISC + 64) + l * 8 + grp;
  const float* smax = (const float*)(p.ws + OFF_MISC);
  const u16* qa = (const u16*)(p.ws + OFF_QA);
  const u16* ka = (const u16*)(p.ws + OFF_KA);
  const u16* vta = (const u16*)(p.ws + OFF_VTA);
  const u16* qb = (const u16*)(p.ws + OFF_QB);
  const u16* kb = (const u16*)(p.ws + OFF_KB);
  const u16* vtb = (const u16*)(p.ws + OFF_VTB);
  u16* G = (u16*)(p.ws + OFF_G);
  const int NIT = l == 3 ? 512 : 544;
  const int hd = grp;
  for (;;) {
    __syncthreads();
    if (opaque_tid() == 0) *s_item = atomicAdd(ctr, 1);
    __syncthreads();
    const int it = *s_item;
    if (it >= NIT) break;
    int kind, b, qt;
    if (it < 512) { kind = it >> 8; b = (it & 255) >> 5; qt = 2 + (it & 31); }
    else { const int r = it - 512; kind = r >> 4; b = (r & 15) >> 1; qt = r & 1; }
    const int q0 = qt * 128;
    const bool lat = qt >= 2;
    if (kind == 0) {
      attn_item<96, false>(qa + hd * 96, 768, ka + hd * 96, 768, vta + ((size_t)(b * 8 + hd) * 64) * SB, b, q0,
                           lat ? 68 : 4, 0, 0, smax[l * 2], 0.f, G + hd * 64, smem);
    } else {
      const int kvh = hd >> 2;
      const float sk = p.sink[l * 8 + hd];
      const float M = fmaxf(smax[l * 2 + 1], sk);
      const float c2 = M * LOG2E;
      const float extra = exp2f(sk * LOG2E - c2);
      int lo2 = 0, nt2 = 0;
      if (lat) {
        lo2 = max(CTXL, q0 - 128);
        const int hi2 = min(SB, q0 + 256);
        nt2 = (hi2 - lo2) >> 6;
      }
      attn_item<64, true>(qb + hd * 64, 512, kb + kvh * 64, 128, vtb + ((size_t)(b * 2 + kvh) * 64) * SB, b, q0, 4,
                          lo2, nt2, c2, extra, G + 512 + hd * 64, smem);
    }
  }
}

DI void phase_glu(const Params& p, int l, char* smem) {
  const u16* yg = (const u16*)(p.ws + OFF_RB);
  const u16* wt = (const u16*)(p.ws + OFF_WGLU + l * SZ_WGLU);
  u16* G = (u16*)(p.ws + OFF_G);
  const float* Cs = (const float*)smem;
  const int tid = opaque_tid();
  const int grp = blockIdx.x & 7, lb = blockIdx.x >> 3, nlb = gridDim.x >> 3;
  for (int j = lb; j < 34 * 8; j += nlb) {
    int mi, nt;
    if (j < 256) { const int rem = j & 63; mi = (j >> 6) * 8 + (rem & 7); nt = rem >> 3; }
    else { const int rem = j - 256; mi = 32 + (rem & 1); nt = rem >> 1; }
    const int mt = grp + 8 * mi;
    if (l == 3 && (mt % 34) < 2) continue;
    const int m0 = mt * 128;
    gemm_tile(yg, 512, wt, 512, 512, m0, nt * 128, smem);
    for (int id = tid; id < 128 * 8; id += 256) {
      const int row = id >> 3, c8 = id & 7;
      u16* gp = G + (size_t)(m0 + row) * 1536 + 1024 + nt * 64 + c8 * 8;
      float gv[8], f[8];
      unpack8(*(const u32x4*)gp, gv);
#pragma unroll
      for (int e = 0; e < 8; ++e) {
        const float za = Cs[row * 129 + c8 * 8 + e], zb = Cs[row * 129 + 64 + c8 * 8 + e];
        f[e] = za * sigmoid_f(zb) * gv[e];
      }
      *(u32x4*)gp = pack8(f);
    }
    __syncthreads();
  }
}

DI void phase_out(const Params& p, int l, char* smem) {
  const u16* G = (const u16*)(p.ws + OFF_G);
  const u16* wt = (const u16*)(p.ws + OFF_WOUT + l * SZ_WOUT);
  const float* Cs = (const float*)smem;
  const float* mod = (const float*)(p.ws + OFF_MOD) + (size_t)l * 9 * 3072;
  const float* xs = l == 0 ? p.x : p.out;
  const float* cs = l == 0 ? p.ctx : (const float*)(p.ws + OFF_CTX);
  float* cd = (float*)(p.ws + OFF_CTX);
  const int tid = opaque_tid();
  const int grp = blockIdx.x & 7, lb = blockIdx.x >> 3, nlb = gridDim.x >> 3;
  for (int j = lb; j < 34 * 8; j += nlb) {
    int mi, nt;
    if (j < 256) { const int rem = j & 63; mi = (j >> 6) * 8 + (rem & 7); nt = rem >> 3; }
    else { const int rem = j - 256; mi = 32 + (rem & 1); nt = rem >> 1; }
    const int mt = grp + 8 * mi;
    if (l == 3 && (mt % 34) < 2) continue;
    const int m0 = mt * 128;
    const int b = m0 / SB, s0 = m0 - b * SB;
    const bool lat = s0 >= CTXL;
    gemm_tile(G, 1536, wt, 1536, 1536, m0, nt * 128, smem);
    const float* gate = mod + (lat ? b : 8) * 3072 + 2048 + nt * 128;
    for (int id = tid; id < 128 * 32; id += 256) {
      const int row = id >> 5, c4 = id & 31;
      const size_t ro = lat ? ((size_t)b * LAT + (s0 + row - CTXL)) * DM : ((size_t)b * CTXL + s0 + row) * DM;
      const float* sp = (lat ? xs : cs) + ro + nt * 128 + c4 * 4;
      float* dp = (lat ? p.out : cd) + ro + nt * 128 + c4 * 4;
      const f32x4 xo = *(const f32x4*)sp;
      const f32x4 gt = *(const f32x4*)(gate + c4 * 4);
      const float* cr = Cs + row * 129 + c4 * 4;
      f32x4 o;
      o.x = xo.x + gt.x * cr[0];
      o.y = xo.y + gt.y * cr[1];
      o.z = xo.z + gt.z * cr[2];
      o.w = xo.w + gt.w * cr[3];
      *(f32x4*)dp = o;
    }
    __syncthreads();
  }
}

__global__ void __launch_bounds__(256, 2) hybrid_fwd(Params p) {
  __shared__ __attribute__((aligned(16))) char smem[SMEM_BYTES];
  __shared__ int s_item;
  __shared__ __attribute__((aligned(16))) unsigned xb_words[4];
  cg::grid_group grid = cg::this_grid();
  if (p.ws == nullptr) grid.sync();
  if (threadIdx.x < 4) xb_words[threadIdx.x] = 0u;
  __syncthreads();
  const XcdBarrier xb = xcd_barrier_post((unsigned*)(p.ws + OFF_MISC + 4096), (volatile LAS unsigned*)xb_words);
  phase0(p, smem);
  xcd_barrier(xb);
  for (int l = 0; l < 4; ++l) {
    phase_norm(p, l);
    xcd_barrier(xb);
    phase_in(p, l, smem);
    xcd_barrier(xb);
    phase_up(p, l, smem);
    xcd_barrier(xb);
    phase_mix(p, l, smem, &s_item);
    xcd_barrier(xb);
    phase_glu(p, l, smem);
    xcd_barrier(xb);
    phase_out(p, l, smem);
    if (l < 3) xcd_barrier(xb);
  }
}

extern "C" void kernel_launch(void* const* d_in, const int* in_sizes, int n_in, void* d_out, int out_size, void* d_ws,
                              size_t ws_size, hipStream_t stream) {
  static int grid_blocks = 0;
  if (!grid_blocks) {
    int dev = 0, cus = 0, per_cu = 0;
    hipGetDevice(&dev);
    hipDeviceGetAttribute(&cus, hipDeviceAttributeMultiprocessorCount, dev);
    hipOccupancyMaxActiveBlocksPerMultiprocessor(&per_cu, hybrid_fwd, 256, 0);
    if (per_cu > 2) per_cu = 2;
    grid_blocks = (cus * per_cu) & ~7;
  }
  if (ws_size < WS_NEED || grid_blocks <= 0) {
    fprintf(stderr, "workspace too small or no occupancy: %zu < %zu, grid %d\n", ws_size, (size_t)WS_NEED, grid_blocks);
    return;
  }
  hipMemsetAsync((char*)d_ws + OFF_MISC, 0, MISC_BYTES, stream);
  Params p{};
  const float** pp = (const float**)&p;
  for (int i = 0; i < 27; ++i) pp[i] = (const float*)d_in[i];
  p.out = (float*)d_out;
  p.ws = (char*)d_ws;
  void* args[] = {&p};
  hipError_t e = hipLaunchCooperativeKernel((void*)hybrid_fwd, dim3(grid_blocks), dim3(256), args, 0, stream);
  if (e != hipSuccess) fprintf(stderr, "cooperative launch failed: %s (grid %d)\n", hipGetErrorString(e), grid_blocks);
}
```
